# Optimizing an MI355X kernel written in HIP

```python
import math
import jax, jax.numpy as jnp
from jax import lax
import numpy as np

D_MODEL = 1024
BATCH = 8
SEQ = 2048
DEPTH = 2
DEC_BATCH = 1
DEC_SEQ = 16384
PAST_LEN = 128

CONV_DIM = 512
CONV_WIDTH = 3
ATTN_HEADS = 8
ATTN_KV_HEADS = 2
ATTN_HEAD_DIM = 64
ATTN_DIM = ATTN_HEADS * ATTN_HEAD_DIM
ATTN_KV_DIM = ATTN_KV_HEADS * ATTN_HEAD_DIM
WINDOW = 128
ATTN_BLOCK = 128
MLSTM_HEADS = 4
MLSTM_HEAD_DIM = 128
MLSTM_DIM = MLSTM_HEADS * MLSTM_HEAD_DIM
MLSTM_CHUNK = 128
FORGET_BIAS = 3.0
M_INIT = -1e30
D_FF = 4 * D_MODEL
RMS_EPS = 1e-6

_IN_SIZES = (CONV_DIM, CONV_DIM, CONV_DIM,
             ATTN_DIM, ATTN_KV_DIM, ATTN_KV_DIM,
             MLSTM_DIM, MLSTM_DIM, MLSTM_DIM, MLSTM_DIM,
             4 * MLSTM_HEADS,
             D_MODEL, D_MODEL, D_MODEL)
N_IN = sum(_IN_SIZES)

kernel_name = "hybrid_bidir_conv_swa_mlstm_encoder"


def _split_cols(u, sizes):
    idx, acc = [], 0
    for s in sizes[:-1]:
        acc += s
        idx.append(acc)
    return jnp.split(u, idx, axis=-1)


def _rmsnorm(x, g):
    xf = x.astype(jnp.float32)
    r = lax.rsqrt(jnp.mean(xf * xf, axis=-1, keepdims=True) + RMS_EPS)
    return (xf * r).astype(x.dtype) * g


def _short_conv(z, w):
    zp = jnp.pad(z, ((0, 0), (1, 1), (0, 0)))
    return w[0] * zp[:, :-2] + w[1] * zp[:, 1:-1] + w[2] * zp[:, 2:]


def _window_attention(q, k, v, sink):
    Bn, S = q.shape[0], q.shape[1]
    nb = S // ATTN_BLOCK
    G = ATTN_HEADS // ATTN_KV_HEADS
    qb = q.reshape(Bn, nb, ATTN_BLOCK, ATTN_KV_HEADS, G, ATTN_HEAD_DIM)
    pad = ((0, 0), (ATTN_BLOCK, ATTN_BLOCK), (0, 0), (0, 0))
    kp = jnp.pad(k, pad).reshape(Bn, nb + 2, ATTN_BLOCK, ATTN_KV_HEADS, ATTN_HEAD_DIM)
    vp = jnp.pad(v, pad).reshape(Bn, nb + 2, ATTN_BLOCK, ATTN_KV_HEADS, ATTN_HEAD_DIM)
    kw = jnp.concatenate([kp[:, :-2], kp[:, 1:-1], kp[:, 2:]], axis=2)
    vw = jnp.concatenate([vp[:, :-2], vp[:, 1:-1], vp[:, 2:]], axis=2)
    scale = ATTN_HEAD_DIM ** -0.5
    s = jnp.einsum('bnqhgd,bnkhd->bnhgqk', qb, kw).astype(jnp.float32) * scale
    rel = (jnp.arange(3 * ATTN_BLOCK)[None, :] - ATTN_BLOCK
           - jnp.arange(ATTN_BLOCK)[:, None])
    keypos = (jnp.arange(nb)[:, None] * ATTN_BLOCK - ATTN_BLOCK
              + jnp.arange(3 * ATTN_BLOCK)[None, :])
    in_range = (keypos >= 0) & (keypos < S)
    valid = (jnp.abs(rel) <= WINDOW)[None, :, :] & in_range[:, None, :]
    slopes = jnp.exp2(-8.0 * (jnp.arange(ATTN_HEADS, dtype=jnp.float32) + 1.0) / ATTN_HEADS)
    slopes = slopes.reshape(ATTN_KV_HEADS, G)
    s = s - slopes[:, :, None, None] * jnp.abs(rel).astype(jnp.float32)
    s = jnp.where(valid[None, :, None, None], s, -jnp.inf)
    sk = sink.astype(jnp.float32).reshape(ATTN_KV_HEADS, G)[:, :, None, None]
    m = jnp.maximum(s.max(axis=-1, keepdims=True), sk)
    p = jnp.exp(s - m)
    denom = p.sum(axis=-1, keepdims=True) + jnp.exp(sk - m)
    out = jnp.einsum('bnhgqk,bnkhd->bnqhgd', (p / denom).astype(v.dtype), vw)
    return out.reshape(Bn, S, ATTN_HEADS * ATTN_HEAD_DIM)


def _mlstm_forward_dir(q, k, v, ig, fg):
    Bn, S, NH, DH = q.shape
    L = MLSTM_CHUNK
    nc = S // L
    qc = q.reshape(Bn, nc, L, NH, DH)
    kc = k.reshape(Bn, nc, L, NH, DH) * (DH ** -0.5)
    vc = v.reshape(Bn, nc, L, NH, DH)
    logf = jnp.swapaxes(jax.nn.log_sigmoid(fg).reshape(Bn, nc, L, NH), -1, -2)
    ii = jnp.swapaxes(ig.reshape(Bn, nc, L, NH), -1, -2)
    b = jnp.cumsum(logf, axis=-1)
    g = b[..., -1]
    w_state = g[..., None] - b + ii
    m_loc = w_state.max(axis=-1)
    e_state = jnp.swapaxes(jnp.exp(w_state - m_loc[..., None]), -1, -2)
    ke = kc * e_state[..., None]
    C_loc = jnp.einsum('bcshv,bcshk->bchvk', vc, ke)
    n_loc = ke.sum(axis=2)

    def step(carry, xs):
        C, n, m = carry
        g_c, m_loc_c, C_loc_c, n_loc_c = xs
        m_new = jnp.maximum(g_c + m, m_loc_c)
        a = jnp.exp(g_c + m - m_new)
        c = jnp.exp(m_loc_c - m_new)
        C_new = a[..., None, None] * C + c[..., None, None] * C_loc_c
        n_new = a[..., None] * n + c[..., None] * n_loc_c
        return (C_new, n_new, m_new), (C, n, m)

    init = (jnp.zeros((Bn, NH, DH, DH), jnp.float32),
            jnp.zeros((Bn, NH, DH), jnp.float32),
            jnp.full((Bn, NH), M_INIT, jnp.float32))
    xs = (jnp.moveaxis(g, 1, 0), jnp.moveaxis(m_loc, 1, 0),
          jnp.moveaxis(C_loc, 1, 0), jnp.moveaxis(n_loc, 1, 0))
    _, (C_prev, n_prev, m_prev) = lax.scan(step, init, xs)
    C_prev = jnp.moveaxis(C_prev, 0, 1)
    n_prev = jnp.moveaxis(n_prev, 0, 1)
    m_prev = jnp.moveaxis(m_prev, 0, 1)

    causal = jnp.tril(jnp.ones((L, L), dtype=bool))
    D = jnp.where(causal, b[..., :, None] - b[..., None, :] + ii[..., None, :], -jnp.inf)
    m_inter = b + m_prev[..., None]
    m_t = jnp.maximum(m_inter, D.max(axis=-1))
    P = jnp.exp(D - m_t[..., None]) * jnp.einsum('bcqhd,bckhd->bchqk', qc, kc)
    a_t = jnp.swapaxes(jnp.exp(m_inter - m_t), -1, -2)
    num = (jnp.einsum('bchqk,bckhd->bcqhd', P, vc)
           + a_t[..., None] * jnp.einsum('bchvk,bcqhk->bcqhv', C_prev, qc))
    den = (jnp.swapaxes(P.sum(axis=-1), -1, -2)
           + a_t * jnp.einsum('bchk,bcqhk->bcqh', n_prev, qc))
    lower = jnp.exp(-jnp.swapaxes(m_t, -1, -2))
    h = num / jnp.maximum(jnp.abs(den), lower)[..., None]
    return h.reshape(Bn, S, NH, DH)


def _layer(x, w_in, conv_w, attn_sink, gate_b, mnorm_g, w_a, w_b, w_c, w_o,
           g_mix, g_mlp, w_up, w_down):
    Bn, S, _ = x.shape
    h = _rmsnorm(x, g_mix)
    u = h @ w_in
    (cb, cc, cx, aq, ak, av, mq, mk, mv, mo, gif, ga, gb, gc) = _split_cols(u, _IN_SIZES)

    y_a = (cb * _short_conv(cc * cx, conv_w)) @ w_a

    att = _window_attention(aq.reshape(Bn, S, ATTN_HEADS, ATTN_HEAD_DIM),
                            ak.reshape(Bn, S, ATTN_KV_HEADS, ATTN_HEAD_DIM),
                            av.reshape(Bn, S, ATTN_KV_HEADS, ATTN_HEAD_DIM), attn_sink)
    y_b = att @ w_b

    gates = (gif + gate_b).astype(jnp.float32)
    i_f, f_f, i_b, f_b = jnp.split(gates, 4, axis=-1)
    shp = (Bn, S, MLSTM_HEADS, MLSTM_HEAD_DIM)
    q = mq.reshape(shp).astype(jnp.float32)
    k = mk.reshape(shp).astype(jnp.float32)
    v = mv.reshape(shp).astype(jnp.float32)
    h_fwd = _mlstm_forward_dir(q, k, v, i_f, f_f)
    h_bwd = jnp.flip(_mlstm_forward_dir(jnp.flip(q, 1), jnp.flip(k, 1), jnp.flip(v, 1),
                                        jnp.flip(i_b, 1), jnp.flip(f_b, 1)), axis=1)
    hm = h_fwd + h_bwd
    hm = hm * lax.rsqrt(jnp.mean(hm * hm, axis=-1, keepdims=True) + RMS_EPS)
    hm = hm.reshape(Bn, S, MLSTM_DIM).astype(x.dtype) * mnorm_g
    y_c = (jax.nn.sigmoid(mo) * hm) @ w_c

    merged = jax.nn.sigmoid(ga) * y_a + jax.nn.sigmoid(gb) * y_b + jax.nn.sigmoid(gc) * y_c
    x = x + merged @ w_o

    h2 = _rmsnorm(x, g_mlp)
    x = x + jnp.square(jax.nn.relu(h2 @ w_up)) @ w_down
    return x


def _trunk(x, w_in, conv_w, attn_sink, mlstm_gate_b, mlstm_norm_g, w_out_a, w_out_b,
           w_out_c, w_o, norm_mix_g, norm_mlp_g, w_mlp_up, w_mlp_down, norm_final_g):
    for l in range(DEPTH):
        x = _layer(x, w_in[l], conv_w[l], attn_sink[l], mlstm_gate_b[l], mlstm_norm_g[l],
                   w_out_a[l], w_out_b[l], w_out_c[l], w_o[l], norm_mix_g[l], norm_mlp_g[l],
                   w_mlp_up[l], w_mlp_down[l])
    return _rmsnorm(x, norm_final_g)


def setup_inputs(seed: int = 0) -> dict:
    key = jax.random.key(seed)
    ks = jax.random.split(key, 20)

    def nrm(k, shape, scale):
        return jax.random.normal(k, shape, jnp.float32) * scale

    gate_offset = jnp.array([0.0, FORGET_BIAS, 0.0, FORGET_BIAS], jnp.float32)[None, :, None]
    mlstm_gate_b = (nrm(ks[5], (DEPTH, 4, MLSTM_HEADS), 0.1) + gate_offset).reshape(DEPTH, 4 * MLSTM_HEADS)
    return {
        "x_prompt": nrm(ks[0], (BATCH, SEQ, D_MODEL), 1.0),
        "x_sample": nrm(ks[1], (DEC_BATCH, DEC_SEQ, D_MODEL), 1.0),
        "w_in": nrm(ks[2], (DEPTH, D_MODEL, N_IN), D_MODEL ** -0.5),
        "conv_w": nrm(ks[3], (DEPTH, CONV_WIDTH, CONV_DIM), CONV_WIDTH ** -0.5),
        "attn_sink": nrm(ks[4], (DEPTH, ATTN_HEADS), 0.5),
        "mlstm_gate_b": mlstm_gate_b,
        "mlstm_norm_g": 1.0 + nrm(ks[6], (DEPTH, MLSTM_DIM), 0.02),
        "w_out_a": nrm(ks[7], (DEPTH, CONV_DIM, D_MODEL), CONV_DIM ** -0.5),
        "w_out_b": nrm(ks[8], (DEPTH, ATTN_DIM, D_MODEL), ATTN_DIM ** -0.5),
        "w_out_c": nrm(ks[9], (DEPTH, MLSTM_DIM, D_MODEL), MLSTM_DIM ** -0.5),
        "w_o": nrm(ks[10], (DEPTH, D_MODEL, D_MODEL), D_MODEL ** -0.5),
        "norm_mix_g": 1.0 + nrm(ks[11], (DEPTH, D_MODEL), 0.02),
        "norm_mlp_g": 1.0 + nrm(ks[12], (DEPTH, D_MODEL), 0.02),
        "w_mlp_up": nrm(ks[13], (DEPTH, D_MODEL, D_FF), D_MODEL ** -0.5),
        "w_mlp_down": nrm(ks[14], (DEPTH, D_FF, D_MODEL), D_FF ** -0.5),
        "norm_final_g": 1.0 + nrm(ks[15], (D_MODEL,), 0.02),
    }


def reference(x_prompt, x_sample, w_in, conv_w, attn_sink, mlstm_gate_b, mlstm_norm_g,
              w_out_a, w_out_b, w_out_c, w_o, norm_mix_g, norm_mlp_g, w_mlp_up, w_mlp_down,
              norm_final_g):
    y_prompt = _trunk(x_prompt, w_in, conv_w, attn_sink, mlstm_gate_b, mlstm_norm_g, w_out_a,
                      w_out_b, w_out_c, w_o, norm_mix_g, norm_mlp_g, w_mlp_up, w_mlp_down,
                      norm_final_g)
    y_sample = _trunk(x_sample, w_in, conv_w, attn_sink, mlstm_gate_b, mlstm_norm_g, w_out_a,
                      w_out_b, w_out_c, w_o, norm_mix_g, norm_mlp_g, w_mlp_up, w_mlp_down,
                      norm_final_g)
    return (y_prompt, y_sample)
```

```cpp
#include <hip/hip_runtime.h>
#include <hip/hip_cooperative_groups.h>
#include <cstdio>
namespace cg = cooperative_groups;

#define LAS __attribute__((address_space(3)))
typedef unsigned short bf16_t;
typedef short bf16x8 __attribute__((ext_vector_type(8)));
typedef float f32x4 __attribute__((ext_vector_type(4)));
typedef float f32x2 __attribute__((ext_vector_type(2)));
typedef float f32x16 __attribute__((ext_vector_type(16)));
typedef unsigned u32x4 __attribute__((ext_vector_type(4)));
typedef unsigned u32x2 __attribute__((ext_vector_type(2)));
typedef __bf16 bf16x2v __attribute__((ext_vector_type(2)));
#define DI __device__ __forceinline__
#define MFMA32(a, b, c) __builtin_amdgcn_mfma_f32_32x32x16_bf16((a), (b), (c), 0, 0, 0)

constexpr int T = 32768, D = 1024, NIN = 7440, TP = 16384;
constexpr float EPS = 1e-6f;
constexpr size_t MB_ARR = (size_t)T * 512 * 2;

constexpr size_t LW_W1A = 0;
constexpr size_t LW_W1B = LW_W1A + (size_t)3328 * 1024 * 2;
constexpr size_t LW_WG  = LW_W1B + (size_t)1280 * 1024 * 2;
constexpr size_t LW_WA  = LW_WG + (size_t)3584 * 1024 * 2;
constexpr size_t LW_WB  = LW_WA + (size_t)1024 * 512 * 2;
constexpr size_t LW_WC  = LW_WB + (size_t)1024 * 512 * 2;
constexpr size_t LW_WO  = LW_WC + (size_t)1024 * 512 * 2;
constexpr size_t LW_WUP = LW_WO + (size_t)1024 * 1024 * 2;
constexpr size_t LW_WDN = LW_WUP + (size_t)4096 * 1024 * 2;
constexpr size_t LW_SIZE = LW_WDN + (size_t)4096 * 1024 * 2;

constexpr size_t WS_W   = 0;
constexpr size_t WS_XB  = WS_W + 2 * LW_SIZE;
constexpr size_t WS_NAT = WS_XB + (size_t)T * 1024 * 2;
constexpr size_t WS_AK  = WS_NAT + 6 * MB_ARR;
constexpr size_t WS_XT  = WS_AK + (size_t)T * 128 * 2;
constexpr size_t WS_ST  = WS_XT + (size_t)1152 * T * 2;
constexpr size_t WS_GATES = WS_ST + (size_t)2 * 1024 * 16384 * 2;
constexpr size_t WS_BARR = WS_GATES + (size_t)T * 16 * 4;
constexpr size_t WS_NL  = WS_BARR + (size_t)8 * T * 4;
constexpr size_t WS_SC  = WS_NL + (size_t)2 * 1024 * 128 * 4;
constexpr size_t WS_SSQ = WS_SC + (size_t)3 * 2048 * 4;
constexpr size_t WS_END = WS_SSQ + (size_t)5 * T * 4;
constexpr size_t WS_HID = WS_NAT;
constexpr size_t WS_SIG0 = WS_NAT + MB_ARR;
constexpr size_t WS_SIG1 = WS_XT + (size_t)128 * T * 2;
constexpr size_t WS_SIG2 = WS_ST;

struct Params { const float* in[16]; float* out; unsigned char* ws; };

DI int otid() { int t = threadIdx.x; asm volatile("" : "+v"(t)); return t; }
DI int obid() { int b = blockIdx.x; asm volatile("" : "+s"(b)); return b; }
DI unsigned pk2(float a, float b) { f32x2 v = {a, b}; bf16x2v r = __builtin_convertvector(v, bf16x2v); return __builtin_bit_cast(unsigned, r); }
DI float bflo(unsigned u) { return __uint_as_float(u << 16); }
DI float bfhi(unsigned u) { return __uint_as_float(u & 0xffff0000u); }
DI float sigmoidf_(float x) { return 1.0f / (1.0f + __expf(-x)); }
DI int swap23(int c) { return (c & ~12) | ((c & 4) << 1) | ((c & 8) >> 1); }
DI bf16x8 pack8(const f32x16& x, int s) {
    u32x4 p;
    if (s == 0) { p.x = pk2(x[0], x[1]); p.y = pk2(x[2], x[3]); p.z = pk2(x[4], x[5]); p.w = pk2(x[6], x[7]); }
    else { p.x = pk2(x[8], x[9]); p.y = pk2(x[10], x[11]); p.z = pk2(x[12], x[13]); p.w = pk2(x[14], x[15]); }
    return __builtin_bit_cast(bf16x8, p);
}

namespace pg8 {
constexpr int BM = 256, BK = 64, HALF = 128, HTB = HALF * BK * 2, STAGE_BYTES = 8 * HTB, NXCD = 8, WGM = 8;
DI int lds_byte(int r, int c) { const int st = (r >> 4) * 2 + (c >> 5), rr = r & 15, cc = c & 31, ob = rr * 64 + cc * 2; return st * 1024 + (ob ^ (((ob >> 9) & 1) << 5)); }
DI void stage_rc(int b, int& R, int& C) { const int st = b / 1024, sb = b % 1024, swz = sb ^ (((sb >> 9) & 1) << 5); R = (st >> 1) * 16 + swz / 64; C = (st & 1) * 32 + (swz % 64) / 2; }
DI int perm32(int rho) { const int n = rho >> 4, i = rho & 15; return 8 * (i >> 2) + 4 * n + (i & 3); }

struct Unit { int pm, pn, kind; const char* A; const char* Bt; };

struct Order {
    int nM0, nN0, n0, nM1, nN1, n1, G, c;
    const char *A0, *B0, *A1, *B1; size_t tstep;
    DI void map(int wgid, int nwg, int nM, int nN, int& pm, int& pn) const {
        { const int q = nwg / NXCD, r = nwg % NXCD, xcd = wgid % NXCD, off = wgid / NXCD; wgid = (xcd < r ? xcd * (q + 1) : r * (q + 1) + (xcd - r) * q) + off; }
        const int nig = WGM * nN, gid = wgid / nig, fm = gid * WGM, gsz = (nM - fm) < WGM ? (nM - fm) : WGM;
        pm = fm + ((wgid % nig) % gsz); pn = (wgid % nig) / gsz;
    }
    DI bool next(int i, Unit& u) const {
        const int L = i * G + c; if (L >= n0 + n1) return false;
        int pm, pn;
        if (L < n0) { map(L, n0, nM0, nN0, pm, pn); u.kind = 0; u.A = A0 + (size_t)pm * tstep; u.Bt = B0 + (size_t)pn * tstep; }
        else { map(L - n0, n1, nM1, nN1, pm, pn); u.kind = 1; u.A = A1 + (size_t)pm * tstep; u.Bt = B1 + (size_t)pn * tstep; }
        u.pm = pm; u.pn = pn; return true;
    }
};

template <class Epi>
DI void gemm_phase(LAS unsigned char* lds, const int K, const Order& S, const Epi& E) {
    const int tid = otid(), wid = __builtin_amdgcn_readfirstlane(tid >> 6), lane = tid & 63, wr = wid >> 2, wc = wid & 3, fr = lane & 15, fq = lane >> 4;
    const int nt = K / BK;
    unsigned voffA[2], voffB[2];
#pragma unroll
    for (int i = 0; i < 2; ++i) { int R, C; stage_rc(tid * 16 + i * 8192, R, C); const int Rb = (R & ~31) + perm32(R & 31);
        voffA[i] = (unsigned)(R * K + C) * 2u; voffB[i] = (unsigned)(Rb * K + C) * 2u; }
    const size_t kstep = (size_t)(BK * 2);
    const size_t hstep = (size_t)HALF * K * 2;
    const unsigned ldsw = (unsigned)wid * 1024u;
    const int aoff = lds_byte(wr * 64 + fr, fq * 8), boff = lds_byte(wc * 32 + fr, fq * 8);
#define PG8_SA(b, h) (((b) * 2 + (h)) * HTB)
#define PG8_SB(b, h) ((4 + (b) * 2 + (h)) * HTB)
#define PG8_STAGE(bufoff, gbase, voff) do { _Pragma("unroll") for (int _i = 0; _i < 2; ++_i) \
        __builtin_amdgcn_global_load_lds((const unsigned*)((const char*)(gbase) + (voff)[_i]), (LAS unsigned*)(lds + (bufoff) + ldsw + _i * 8192), 16, 0, 0); } while (0)
#define PG8_LDA(dst, b, h) do { _Pragma("unroll") for (int m = 0; m < 4; ++m) _Pragma("unroll") for (int k = 0; k < 2; ++k) dst[m][k] = *(const LAS bf16x8*)(lds + PG8_SA(b, h) + aoff + m * 2048 + k * 1024); } while (0)
#define PG8_LDB(dst, b, h) do { _Pragma("unroll") for (int n = 0; n < 2; ++n) _Pragma("unroll") for (int k = 0; k < 2; ++k) dst[n][k] = *(const LAS bf16x8*)(lds + PG8_SB(b, h) + boff + n * 2048 + k * 1024); } while (0)
#define PG8_MMA(ai, bj, At, Bt) do { __builtin_amdgcn_s_setprio(1); _Pragma("unroll") for (int m = 0; m < 4; ++m) _Pragma("unroll") for (int n = 0; n < 2; ++n) _Pragma("unroll") for (int k = 0; k < 2; ++k) \
        acc[ai][bj][m][n] = __builtin_amdgcn_mfma_f32_16x16x32_bf16(Bt[n][k], At[m][k], acc[ai][bj][m][n], 0, 0, 0); __builtin_amdgcn_s_setprio(0); } while (0)
#define PG8_WAIT_V(n) asm volatile("s_waitcnt vmcnt(" #n ")" ::: "memory")
#define PG8_WAIT_L(n) asm volatile("s_waitcnt lgkmcnt(" #n ")" ::: "memory")
#define PG8_BAR __builtin_amdgcn_s_barrier()
#define PG8_SCHED __builtin_amdgcn_sched_barrier(0)
    Unit cur, nxt; int ui = 0;
    if (!S.next(0, cur)) return;
    f32x4 acc[2][2][4][2];
#pragma unroll
    for (int a = 0; a < 2; ++a)
#pragma unroll
        for (int b = 0; b < 2; ++b)
#pragma unroll
            for (int m = 0; m < 4; ++m)
#pragma unroll
                for (int n = 0; n < 2; ++n) acc[a][b][m][n] = (f32x4){0.f, 0.f, 0.f, 0.f};
    bf16x8 At[4][2], B0[2][2], B1[2][2];
    const char* cA = cur.A; const char* cB = cur.Bt;
    PG8_STAGE(PG8_SB(0, 0), cB, voffB); PG8_STAGE(PG8_SA(0, 0), cA, voffA); PG8_STAGE(PG8_SB(0, 1), cB + hstep, voffB); PG8_STAGE(PG8_SA(0, 1), cA + hstep, voffA);
    if (wr == 1) PG8_BAR;
    PG8_WAIT_V(4); PG8_BAR;
    PG8_STAGE(PG8_SB(1, 0), cB + kstep, voffB); PG8_STAGE(PG8_SA(1, 0), cA + kstep, voffA); PG8_STAGE(PG8_SB(1, 1), cB + hstep + kstep, voffB);
    PG8_WAIT_V(6); PG8_BAR;
    for (;;) {
        const bool has_next = S.next(ui + 1, nxt);
        const char* nA = has_next ? nxt.A : cA; const char* nB = has_next ? nxt.Bt : cB;
        for (int t = 0; t < nt; t += 2) {
            const bool last = (t == nt - 2);
            const char* a1 = cA + (size_t)(t + 1) * kstep;
            const char* a2 = last ? nA : cA + (size_t)(t + 2) * kstep; const char* b2 = last ? nB : cB + (size_t)(t + 2) * kstep;
            const char* a3 = a2 + kstep; const char* b3 = b2 + kstep;
            PG8_LDB(B0, 0, 0); PG8_SCHED; PG8_LDA(At, 0, 0); PG8_STAGE(PG8_SA(1, 1), a1 + hstep, voffA);
            PG8_WAIT_L(8); PG8_BAR; PG8_WAIT_L(0); PG8_MMA(0, 0, At, B0); PG8_BAR; PG8_SCHED;
            PG8_LDB(B1, 0, 1); PG8_STAGE(PG8_SB(0, 0), b2, voffB);
            PG8_BAR; PG8_WAIT_L(0); PG8_MMA(0, 1, At, B1); PG8_BAR;
            PG8_LDA(At, 0, 1); PG8_STAGE(PG8_SA(0, 0), a2, voffA);
            PG8_BAR; PG8_WAIT_L(0); PG8_MMA(1, 0, At, B0); PG8_BAR; PG8_SCHED;
            PG8_STAGE(PG8_SB(0, 1), b2 + hstep, voffB);
            PG8_WAIT_V(6); PG8_BAR; PG8_MMA(1, 1, At, B1); PG8_BAR;
            PG8_LDB(B0, 1, 0); PG8_SCHED; PG8_LDA(At, 1, 0); PG8_STAGE(PG8_SA(0, 1), a2 + hstep, voffA);
            PG8_WAIT_L(8); PG8_BAR; PG8_WAIT_L(0); PG8_MMA(0, 0, At, B0); PG8_BAR; PG8_SCHED;
            PG8_LDB(B1, 1, 1); PG8_STAGE(PG8_SB(1, 0), b3, voffB);
            PG8_BAR; PG8_WAIT_L(0); PG8_MMA(0, 1, At, B1); PG8_BAR;
            PG8_LDA(At, 1, 1); PG8_STAGE(PG8_SA(1, 0), a3, voffA);
            PG8_BAR; PG8_WAIT_L(0); PG8_MMA(1, 0, At, B0); PG8_BAR; PG8_SCHED;
            PG8_STAGE(PG8_SB(1, 1), b3 + hstep, voffB);
            PG8_WAIT_V(6); PG8_BAR; PG8_MMA(1, 1, At, B1); PG8_BAR;
        }
        E(acc, cur, wr, wc, fr, fq);
        if (!has_next) break;
#pragma unroll
        for (int a = 0; a < 2; ++a)
#pragma unroll
            for (int b = 0; b < 2; ++b)
#pragma unroll
                for (int m = 0; m < 4; ++m)
#pragma unroll
                    for (int n = 0; n < 2; ++n) acc[a][b][m][n] = (f32x4){0.f, 0.f, 0.f, 0.f};
        cur = nxt; cA = nA; cB = nB; ++ui;
    }
    PG8_WAIT_V(0);
    if (wr == 0) PG8_BAR;
    PG8_BAR;
#undef PG8_SA
#undef PG8_SB
#undef PG8_STAGE
#undef PG8_LDA
#undef PG8_LDB
#undef PG8_MMA
#undef PG8_WAIT_V
#undef PG8_WAIT_L
#undef PG8_BAR
#undef PG8_SCHED
}
}
using pg8::Unit;
typedef f32x4 AccT[2][2][4][2];

DI u32x4 pack8v(f32x4 v0, f32x4 v1) { u32x4 w; w.x = pk2(v0[0], v0[1]); w.y = pk2(v0[2], v0[3]); w.z = pk2(v1[0], v1[1]); w.w = pk2(v1[2], v1[3]); return w; }
DI void unpack8(u32x4 w, f32x4& v0, f32x4& v1) { v0 = (f32x4){bflo(w.x), bfhi(w.x), bflo(w.y), bfhi(w.y)}; v1 = (f32x4){bflo(w.z), bfhi(w.z), bflo(w.w), bfhi(w.w)}; }

struct EpiP1 {
    unsigned char* ws; const float* ssq; const float* gate_b;
    DI void operator()(const AccT& acc, const Unit& u, int wr, int wc, int fr, int fq) const {
        if (u.kind == 0) {
            const int pn = u.pn, row0 = u.pm * 256 + wr * 64 + fr, colt = wc * 32 + fq * 8;
            bf16_t* ak = (bf16_t*)(ws + WS_AK); float* gates = (float*)(ws + WS_GATES);
            const int arr = pn < 8 ? (pn >> 1) : 4 + ((pn - 9) >> 1), half = pn < 8 ? (pn & 1) : ((pn - 9) & 1);
            bf16_t* nat = (bf16_t*)(ws + WS_NAT) + (size_t)arr * T * 512 + half * 256 + colt;
#pragma unroll
            for (int ai = 0; ai < 2; ++ai)
#pragma unroll
                for (int m = 0; m < 4; ++m) {
                    const int row = row0 + ai * 128 + m * 16;
                    const float r = __builtin_amdgcn_rsqf(ssq[row] * (1.0f / 1024.0f) + EPS);
#pragma unroll
                    for (int bj = 0; bj < 2; ++bj) {
                        const f32x4 v0 = acc[ai][bj][m][0] * r, v1 = acc[ai][bj][m][1] * r;
                        if (pn != 8) { *(u32x4*)(nat + (size_t)row * 512 + bj * 128) = pack8v(v0, v1); }
                        else if (bj == 0) { *(u32x4*)(ak + (size_t)row * 128 + colt) = pack8v(v0, v1); }
                        else if (wc == 0 && fq < 2) {
                            const f32x4 b0 = *(const f32x4*)(gate_b + fq * 8), b1 = *(const f32x4*)(gate_b + fq * 8 + 4);
                            *(f32x4*)(gates + (size_t)row * 16 + fq * 8) = v0 + b0; *(f32x4*)(gates + (size_t)row * 16 + fq * 8 + 4) = v1 + b1;
                        }
                    }
                }
        } else {
            bf16_t* xt = (bf16_t*)(ws + WS_XT);
            const int tok0 = u.pn * 256 + wc * 32 + fq * 8, f0 = u.pm * 256 + wr * 64 + fr;
            f32x4 rs[2][2];
#pragma unroll
            for (int bj = 0; bj < 2; ++bj)
#pragma unroll
                for (int n = 0; n < 2; ++n) { const f32x4 s = *(const f32x4*)(ssq + tok0 + bj * 128 + n * 4);
#pragma unroll
                    for (int j = 0; j < 4; ++j) rs[bj][n][j] = __builtin_amdgcn_rsqf(s[j] * (1.0f / 1024.0f) + EPS); }
#pragma unroll
            for (int ai = 0; ai < 2; ++ai) {
                if (u.pm == 0 && ai == 1) continue;
#pragma unroll
                for (int m = 0; m < 4; ++m) {
                    const int f = f0 + ai * 128 + m * 16; const int xr = f < 128 ? f : f - 128;
#pragma unroll
                    for (int bj = 0; bj < 2; ++bj)
                        *(u32x4*)(xt + (size_t)xr * T + tok0 + bj * 128) = pack8v(acc[ai][bj][m][0] * rs[bj][0], acc[ai][bj][m][1] * rs[bj][1]);
                }
            }
        }
    }
};

struct EpiGates {
    unsigned char* ws; const float* ssq;
    DI void operator()(const AccT& acc, const Unit& u, int wr, int wc, int fr, int fq) const {
        const int pn = u.pn, row0 = u.pm * 256 + wr * 64 + fr, colt = wc * 32 + fq * 8;
        bf16_t* dst; int ld;
        if (pn < 12) { const int br = pn >> 2; dst = (bf16_t*)(ws + (br == 0 ? WS_SIG0 : (br == 1 ? WS_SIG1 : WS_SIG2))) + (pn & 3) * 256 + colt; ld = 1024; }
        else { dst = (bf16_t*)(ws + WS_NAT + 4 * MB_ARR) + (pn - 12) * 256 + colt; ld = 512; }
#pragma unroll
        for (int ai = 0; ai < 2; ++ai)
#pragma unroll
            for (int m = 0; m < 4; ++m) {
                const int row = row0 + ai * 128 + m * 16;
                const float r = __builtin_amdgcn_rsqf(ssq[row] * (1.0f / 1024.0f) + EPS);
#pragma unroll
                for (int bj = 0; bj < 2; ++bj) {
                    f32x4 v0 = acc[ai][bj][m][0] * r, v1 = acc[ai][bj][m][1] * r;
#pragma unroll
                    for (int j = 0; j < 4; ++j) { v0[j] = sigmoidf_(v0[j]); v1[j] = sigmoidf_(v1[j]); }
                    u32x4* p = (u32x4*)(dst + (size_t)row * ld + bj * 128);
                    if (pn >= 12) { f32x4 h0, h1; unpack8(*p, h0, h1); v0 *= h0; v1 *= h1; }
                    *p = pack8v(v0, v1);
                }
            }
    }
};

template <int BR> struct EpiY {
    unsigned char* ws;
    DI void operator()(const AccT& acc, const Unit& u, int wr, int wc, int fr, int fq) const {
        const int row0 = u.pm * 256 + wr * 64 + fr, col = u.pn * 256 + wc * 32 + fq * 8;
        bf16_t* mg = (bf16_t*)(ws + WS_SIG0) + col;
        const bf16_t* sg = (const bf16_t*)(ws + (BR == 0 ? WS_SIG0 : (BR == 1 ? WS_SIG1 : WS_SIG2))) + col;
#pragma unroll
        for (int ai = 0; ai < 2; ++ai)
#pragma unroll
            for (int m = 0; m < 4; ++m) {
                const int row = row0 + ai * 128 + m * 16;
#pragma unroll
                for (int bj = 0; bj < 2; ++bj) {
                    f32x4 g0, g1; unpack8(*(const u32x4*)(sg + (size_t)row * 1024 + bj * 128), g0, g1);
                    f32x4 v0 = acc[ai][bj][m][0] * g0, v1 = acc[ai][bj][m][1] * g1;
                    u32x4* p = (u32x4*)(mg + (size_t)row * 1024 + bj * 128);
                    if (BR > 0) { f32x4 o0, o1; unpack8(*p, o0, o1); v0 += o0; v1 += o1; }
                    *p = pack8v(v0, v1);
                }
            }
    }
};

struct EpiRes {
    const float* x0; const float* x1; float* out; bf16_t* xb; float* ssq_next; int first;
    DI void operator()(const AccT& acc, const Unit& u, int wr, int wc, int fr, int fq) const {
        const int row0 = u.pm * 256 + wr * 64 + fr, col = u.pn * 256 + wc * 32 + fq * 8;
#pragma unroll
        for (int ai = 0; ai < 2; ++ai)
#pragma unroll
            for (int m = 0; m < 4; ++m) {
                const int row = row0 + ai * 128 + m * 16;
                const float* xs = first ? (row < TP ? x0 + (size_t)row * D : x1 + (size_t)(row - TP) * D) : out + (size_t)row * D;
                float s = 0.f;
#pragma unroll
                for (int bj = 0; bj < 2; ++bj) {
                    const f32x4 a0 = *(const f32x4*)(xs + col + bj * 128), a1 = *(const f32x4*)(xs + col + bj * 128 + 4);
                    const f32x4 v0 = acc[ai][bj][m][0] + a0, v1 = acc[ai][bj][m][1] + a1;
                    *(f32x4*)(out + (size_t)row * D + col + bj * 128) = v0; *(f32x4*)(out + (size_t)row * D + col + bj * 128 + 4) = v1;
                    *(u32x4*)(xb + (size_t)row * D + col + bj * 128) = pack8v(v0, v1);
#pragma unroll
                    for (int j = 0; j < 4; ++j) s += v0[j] * v0[j] + v1[j] * v1[j];
                }
                s += __shfl_xor(s, 16); s += __shfl_xor(s, 32);
                if (fq == 0) atomicAdd(ssq_next + row, s);
            }
    }
};

struct EpiUp {
    bf16_t* hid; const float* ssq;
    DI void operator()(const AccT& acc, const Unit& u, int wr, int wc, int fr, int fq) const {
        const int row0 = u.pm * 256 + wr * 64 + fr, col = u.pn * 256 + wc * 32 + fq * 8;
#pragma unroll
        for (int ai = 0; ai < 2; ++ai)
#pragma unroll
            for (int m = 0; m < 4; ++m) {
                const int row = row0 + ai * 128 + m * 16;
                const float r = __builtin_amdgcn_rsqf(ssq[row] * (1.0f / 1024.0f) + EPS);
#pragma unroll
                for (int bj = 0; bj < 2; ++bj) {
                    f32x4 v0 = acc[ai][bj][m][0] * r, v1 = acc[ai][bj][m][1] * r;
#pragma unroll
                    for (int j = 0; j < 4; ++j) { const float a = fmaxf(v0[j], 0.f), b = fmaxf(v1[j], 0.f); v0[j] = a * a; v1[j] = b * b; }
                    *(u32x4*)(hid + (size_t)row * 4096 + col + bj * 128) = pack8v(v0, v1);
                }
            }
    }
};

DI void prep_seg(LAS float* tile, bf16_t* dst, int drow0, int nrows, const float* src, int ld, int col0, int valid, int K, const float* g, int rot) {
    const int ntn = nrows / 64, ntk = K / 64, tid = otid(), nb = gridDim.x;
    for (int t = (obid() + nb - (rot % nb)) % nb; t < ntn * ntk; t += nb) {
        const int tn = t % ntn, tk = t / ntn;
#pragma unroll
        for (int i = 0; i < 8; ++i) {
            const int e = tid + 512 * i, kr = e >> 6, nc = e & 63, n = tn * 64 + nc, k = tk * 64 + kr;
            float v = 0.f;
            if (n < valid) { v = src[(size_t)k * ld + col0 + n]; if (g) v *= g[k]; }
            tile[kr * 65 + nc] = v;
        }
        __syncthreads();
#pragma unroll
        for (int i = 0; i < 4; ++i) {
            const int e = tid + 512 * i, nr = e >> 5, kp = e & 31;
            *(unsigned*)(dst + (size_t)(drow0 + tn * 64 + nr) * K + tk * 64 + 2 * kp) = pk2(tile[(2 * kp) * 65 + nr], tile[(2 * kp + 1) * 65 + nr]);
        }
        __syncthreads();
    }
}

DI void phase_prep(const Params& p, LAS unsigned char* lds) {
    LAS float* tile = (LAS float*)lds;
    int rot = 0;
    for (int l = 0; l < 2; ++l) {
        unsigned char* wb = p.ws + WS_W + (size_t)l * LW_SIZE;
        const float* win = p.in[2] + (size_t)l * D * NIN; const float* gmix = p.in[11] + l * D; const float* gmlp = p.in[12] + l * D;
        bf16_t* w1a = (bf16_t*)(wb + LW_W1A); bf16_t* w1b = (bf16_t*)(wb + LW_W1B); bf16_t* wg = (bf16_t*)(wb + LW_WG);
        prep_seg(tile, w1a, 0, 2048, win, NIN, 0, 2048, 1024, gmix, rot); rot += 512;
        prep_seg(tile, w1a, 2048, 128, win, NIN, 2048, 128, 1024, gmix, rot); rot += 32;
        prep_seg(tile, w1a, 2176, 128, win, NIN, 4352, 16, 1024, gmix, rot); rot += 32;
        prep_seg(tile, w1a, 2304, 1024, win, NIN, 2304, 1024, 1024, gmix, rot); rot += 256;
        prep_seg(tile, w1b, 0, 256, win, NIN, 2176, 128, 1024, gmix, rot); rot += 64;
        prep_seg(tile, w1b, 256, 1024, win, NIN, 2816, 1024, 1024, gmix, rot); rot += 256;
        prep_seg(tile, wg, 0, 3072, win, NIN, 4368, 3072, 1024, gmix, rot); rot += 768;
        prep_seg(tile, wg, 3072, 512, win, NIN, 3840, 512, 1024, gmix, rot); rot += 128;
        prep_seg(tile, (bf16_t*)(wb + LW_WA), 0, 1024, p.in[7] + (size_t)l * 512 * D, D, 0, 1024, 512, nullptr, rot); rot += 128;
        prep_seg(tile, (bf16_t*)(wb + LW_WB), 0, 1024, p.in[8] + (size_t)l * 512 * D, D, 0, 1024, 512, nullptr, rot); rot += 128;
        prep_seg(tile, (bf16_t*)(wb + LW_WC), 0, 1024, p.in[9] + (size_t)l * 512 * D, D, 0, 1024, 512, nullptr, rot); rot += 128;
        prep_seg(tile, (bf16_t*)(wb + LW_WO), 0, 1024, p.in[10] + (size_t)l * D * D, D, 0, 1024, 1024, nullptr, rot); rot += 256;
        prep_seg(tile, (bf16_t*)(wb + LW_WUP), 0, 4096, p.in[13] + (size_t)l * D * 4096, 4096, 0, 4096, 1024, gmlp, rot); rot += 1024;
        prep_seg(tile, (bf16_t*)(wb + LW_WDN), 0, 1024, p.in[14] + (size_t)l * 4096 * D, D, 0, 1024, 4096, nullptr, rot); rot += 1024;
    }
    const int tid0 = otid(), lane = tid0 & 63, gw = obid() * 8 + (tid0 >> 6), NW = gridDim.x * 8;
    bf16_t* xb = (bf16_t*)(p.ws + WS_XB); float* ssq = (float*)(p.ws + WS_SSQ);
    for (int row = gw; row < T; row += NW) {
        const float* x = row < TP ? p.in[0] + (size_t)row * D : p.in[1] + (size_t)(row - TP) * D;
        float s = 0.f;
#pragma unroll
        for (int i = 0; i < 4; ++i) {
            const f32x4 v = *(const f32x4*)(x + i * 256 + lane * 4);
            s += v[0] * v[0] + v[1] * v[1] + v[2] * v[2] + v[3] * v[3];
            u32x2 w; w.x = pk2(v[0], v[1]); w.y = pk2(v[2], v[3]);
            *(u32x2*)(xb + (size_t)row * D + i * 256 + lane * 4) = w;
        }
#pragma unroll
        for (int d = 32; d >= 1; d >>= 1) s += __shfl_xor(s, d);
        if (lane == 0) ssq[row] = s;
    }
    for (int i = obid() * 512 + tid0; i < 4 * T; i += gridDim.x * 512) ssq[T + i] = 0.f;
}

DI void seq_bounds(int t, int& lo, int& hi) { if (t < TP) { lo = t & ~2047; hi = lo + 2048; } else { lo = TP; hi = T; } }

DI void conv_phase(const Params& p, int l) {
    bf16_t* cb = (bf16_t*)(p.ws + WS_NAT); const bf16_t* cc = cb + (size_t)T * 512; const bf16_t* cx = cc + (size_t)T * 512;
    const float* cw = p.in[3] + l * 3 * 512;
    for (int it = obid() * 512 + otid(); it < T * 64; it += gridDim.x * 512) {
        const int t = it >> 6, c0 = (it & 63) * 8;
        int lo, hi; seq_bounds(t, lo, hi);
        float accv[8];
#pragma unroll
        for (int j = 0; j < 8; ++j) accv[j] = 0.f;
#pragma unroll
        for (int dt = -1; dt <= 1; ++dt) {
            const int tt = t + dt;
            if (tt >= lo && tt < hi) {
                const u32x4 a = *(const u32x4*)(cc + (size_t)tt * 512 + c0), b = *(const u32x4*)(cx + (size_t)tt * 512 + c0);
                f32x4 a0, a1, b0, b1; unpack8(a, a0, a1); unpack8(b, b0, b1);
                const f32x4 w0 = *(const f32x4*)(cw + (dt + 1) * 512 + c0), w1 = *(const f32x4*)(cw + (dt + 1) * 512 + c0 + 4);
#pragma unroll
                for (int j = 0; j < 4; ++j) { accv[j] += w0[j] * a0[j] * b0[j]; accv[4 + j] += w1[j] * a1[j] * b1[j]; }
            }
        }
        u32x4* pb = (u32x4*)(cb + (size_t)t * 512 + c0);
        f32x4 g0, g1; unpack8(*pb, g0, g1);
        f32x4 r0, r1;
#pragma unroll
        for (int j = 0; j < 4; ++j) { r0[j] = g0[j] * accv[j]; r1[j] = g1[j] * accv[4 + j]; }
        *pb = pack8v(r0, r1);
    }
}

DI f32x16 attn_scores(bool edge, int kb, int tq, int hh, const bf16_t* kp, const bf16x8 (&qf)[4], float slope) {
    f32x16 a;
#pragma unroll
    for (int v = 0; v < 16; ++v) a[v] = 0.f;
#pragma unroll
    for (int ks = 0; ks < 4; ++ks) { const bf16x8 kf = *(const bf16x8*)(kp + ks * 16); a = MFMA32(kf, qf[ks], a); }
#pragma unroll
    for (int v = 0; v < 16; ++v) {
        const int key = kb + (v & 7) + 8 * hh + 16 * (v >> 3);
        const int ar = key > tq ? key - tq : tq - key;
        float s = a[v] * 0.125f - slope * (float)ar;
        s = (edge && ar > 128) ? -INFINITY : s;
        a[v] = s;
    }
    return a;
}

DI void attn_item(int strip, int h, bf16_t* aq, const bf16_t* ak, const bf16_t* avT, float sink, int lane) {
    const int c = lane & 31, hh = lane >> 5, t0 = strip * 32, hk = h >> 2, tq = t0 + c;
    int lo, hi; seq_bounds(t0, lo, hi);
    const float slope = exp2f(-(float)(h + 1));
    bf16x8 qf[4];
#pragma unroll
    for (int ks = 0; ks < 4; ++ks) qf[ks] = *(const bf16x8*)(aq + (size_t)tq * 512 + h * 64 + ks * 16 + hh * 8);
    const int krow = swap23(c);
    float mx = -INFINITY;
#pragma unroll 1
    for (int kt = 0; kt < 9; ++kt) {
        const int kb = t0 - 128 + 32 * kt;
        if (kb >= lo && kb < hi) {
            const f32x16 a = attn_scores(kt == 0 || kt == 8, kb, tq, hh, ak + (size_t)(kb + krow) * 128 + hk * 64 + hh * 8, qf, slope);
#pragma unroll
            for (int v = 0; v < 16; ++v) mx = fmaxf(mx, a[v]);
        }
    }
    mx = fmaxf(mx, __shfl_xor(mx, 32)); mx = fmaxf(mx, sink);
    float sum = 0.f;
    f32x16 o0, o1;
#pragma unroll
    for (int v = 0; v < 16; ++v) { o0[v] = 0.f; o1[v] = 0.f; }
#pragma unroll 1
    for (int kt = 0; kt < 9; ++kt) {
        const int kb = t0 - 128 + 32 * kt;
        if (kb >= lo && kb < hi) {
            f32x16 a = attn_scores(kt == 0 || kt == 8, kb, tq, hh, ak + (size_t)(kb + krow) * 128 + hk * 64 + hh * 8, qf, slope);
#pragma unroll
            for (int v = 0; v < 16; ++v) { const float pe = __expf(a[v] - mx); a[v] = pe; sum += pe; }
#pragma unroll
            for (int s = 0; s < 2; ++s) {
                const bf16x8 pf = pack8(a, s);
                const bf16x8 v0 = *(const bf16x8*)(avT + (size_t)(hk * 64 + c) * T + kb + 16 * s + 8 * hh);
                const bf16x8 v1 = *(const bf16x8*)(avT + (size_t)(hk * 64 + 32 + c) * T + kb + 16 * s + 8 * hh);
                o0 = MFMA32(v0, pf, o0); o1 = MFMA32(v1, pf, o1);
            }
        }
    }
    sum += __shfl_xor(sum, 32); sum += __expf(sink - mx);
    const float inv = 1.0f / sum;
    bf16_t* op = aq + (size_t)tq * 512 + h * 64 + 4 * hh;
#pragma unroll
    for (int g = 0; g < 4; ++g) {
        u32x2 w0, w1;
        w0.x = pk2(o0[4 * g] * inv, o0[4 * g + 1] * inv); w0.y = pk2(o0[4 * g + 2] * inv, o0[4 * g + 3] * inv);
        w1.x = pk2(o1[4 * g] * inv, o1[4 * g + 1] * inv); w1.y = pk2(o1[4 * g + 2] * inv, o1[4 * g + 3] * inv);
        *(u32x2*)(op + 8 * g) = w0; *(u32x2*)(op + 32 + 8 * g) = w1;
    }
}

DI float logsigmoidf_(float x) { return fminf(x, 0.f) - log1pf(expf(-fabsf(x))); }
DI float scan_up(float v, int lane) {
#pragma unroll
    for (int d = 1; d < 64; d <<= 1) { const float t = __shfl_up(v, d); if (lane >= d) v += t; }
    return v;
}
DI float scan_down(float v, int lane) {
#pragma unroll
    for (int d = 1; d < 64; d <<= 1) { const float t = __shfl_down(v, d); if (lane + d < 64) v += t; }
    return v;
}
DI float wave_max(float v) {
#pragma unroll
    for (int d = 32; d >= 1; d >>= 1) v = fmaxf(v, __shfl_xor(v, d));
    return v;
}
#define LDS_FENCE() asm volatile("s_waitcnt lgkmcnt(0)" ::: "memory")

DI void mstat_item(int cg, int hd, int dir, unsigned char* ws, LAS float* wl, int lane) {
    const int tb = cg * 128, c = lane & 31, hh = lane >> 5, item = cg * 4 + hd;
    const float* gates = (const float*)(ws + WS_GATES);
    const float ig0 = gates[(size_t)(tb + lane) * 16 + dir * 8 + hd], fg0 = gates[(size_t)(tb + lane) * 16 + dir * 8 + 4 + hd];
    const float ig1 = gates[(size_t)(tb + 64 + lane) * 16 + dir * 8 + hd], fg1 = gates[(size_t)(tb + 64 + lane) * 16 + dir * 8 + 4 + hd];
    const float lf0 = logsigmoidf_(fg0), lf1 = logsigmoidf_(fg1);
    float b0, b1, g;
    if (dir == 0) { b0 = scan_up(lf0, lane); const float t0 = __shfl(b0, 63); b1 = scan_up(lf1, lane) + t0; g = __shfl(b1, 63); }
    else { b1 = scan_down(lf1, lane); const float t1 = __shfl(b1, 0); b0 = scan_down(lf0, lane) + t1; g = __shfl(b0, 0); }
    const float w0 = g - b0 + ig0, w1 = g - b1 + ig1;
    const float mloc = wave_max(fmaxf(w0, w1));
    const float DHS = 0.08838834764831845f;
    float* barr = (float*)(ws + WS_BARR) + (size_t)(dir * 4 + hd) * T + tb;
    barr[lane] = b0; barr[64 + lane] = b1;
    LDS_FENCE();
    wl[lane] = __expf(w0 - mloc) * DHS; wl[64 + lane] = __expf(w1 - mloc) * DHS;
    LDS_FENCE();
    float* sc = (float*)(ws + WS_SC);
    if (lane == 0) { sc[dir * 1024 + item] = g; sc[2048 + dir * 1024 + item] = mloc; }
    const bf16_t* mkT = (const bf16_t*)(ws + WS_XT) + (size_t)128 * T + (size_t)(hd * 128) * T + tb;
    const bf16_t* mvT = mkT + (size_t)512 * T;
    bf16_t* st = (bf16_t*)(ws + WS_ST) + (size_t)(dir * 1024 + item) * 16384;
#pragma unroll 1
    for (int vt = 0; vt < 4; ++vt) {
        bf16x8 vb[8];
#pragma unroll
        for (int ks = 0; ks < 8; ++ks) {
            const u32x4 raw = *(const u32x4*)(mvT + (size_t)(vt * 32 + c) * T + 16 * ks + 8 * hh);
            const f32x4 e0 = *(const LAS f32x4*)(wl + 16 * ks + 8 * hh), e1 = *(const LAS f32x4*)(wl + 16 * ks + 8 * hh + 4);
            f32x4 x0, x1; unpack8(raw, x0, x1);
            vb[ks] = __builtin_bit_cast(bf16x8, pack8v(x0 * e0, x1 * e1));
        }
#pragma unroll
        for (int kt = 0; kt < 4; ++kt) {
            f32x16 acc;
#pragma unroll
            for (int v = 0; v < 16; ++v) acc[v] = 0.f;
#pragma unroll
            for (int ks = 0; ks < 8; ++ks) { const bf16x8 kf = *(const bf16x8*)(mkT + (size_t)(kt * 32 + c) * T + 16 * ks + 8 * hh); acc = MFMA32(kf, vb[ks], acc); }
#pragma unroll
            for (int gq = 0; gq < 4; ++gq) {
                u32x2 w; w.x = pk2(acc[4 * gq], acc[4 * gq + 1]); w.y = pk2(acc[4 * gq + 2], acc[4 * gq + 3]);
                *(u32x2*)(st + (size_t)(vt * 32 + c) * 128 + kt * 32 + 8 * gq + 4 * hh) = w;
            }
        }
    }
    float* nl = (float*)(ws + WS_NL) + (size_t)(dir * 1024 + item) * 128;
#pragma unroll 1
    for (int kk = 0; kk < 2; ++kk) {
        const int k = lane + 64 * kk; float s = 0.f;
#pragma unroll 4
        for (int s8 = 0; s8 < 16; ++s8) {
            const u32x4 raw = *(const u32x4*)(mkT + (size_t)k * T + 8 * s8);
            const f32x4 e0 = *(const LAS f32x4*)(wl + 8 * s8), e1 = *(const LAS f32x4*)(wl + 8 * s8 + 4);
            f32x4 x0, x1; unpack8(raw, x0, x1);
#pragma unroll
            for (int j = 0; j < 4; ++j) s += x0[j] * e0[j] + x1[j] * e1[j];
        }
        nl[k] = s;
    }
    LDS_FENCE();
}

DI void phase_mix(const Params& p, int l, LAS unsigned char* lds) {
    const int tid0 = otid(), lane = tid0 & 63, wid = tid0 >> 6, gw = obid() * 8 + wid, NW = gridDim.x * 8;
    LAS float* wl = (LAS float*)(lds + wid * 4096);
    for (int it = gw; it < 2048; it += NW) mstat_item(it >> 3, (it >> 1) & 3, it & 1, p.ws, wl, lane);
    bf16_t* aq = (bf16_t*)(p.ws + WS_NAT + 3 * MB_ARR); const bf16_t* ak = (const bf16_t*)(p.ws + WS_AK); const bf16_t* avT = (const bf16_t*)(p.ws + WS_XT);
    for (int it = gw; it < 8192; it += NW) { const int h = it & 7; attn_item(it >> 3, h, aq, ak, avT, p.in[4][l * 8 + h], lane); }
    conv_phase(p, l);
}

DI void phase_scan(const Params& p) {
    const int gt = obid() * 512 + otid(), NT = gridDim.x * 512;
    const float* sc = (const float*)(p.ws + WS_SC); float* mprev = (float*)(p.ws + WS_SC) + 4096;
    bf16_t* st = (bf16_t*)(p.ws + WS_ST); float* nl = (float*)(p.ws + WS_NL);
    for (int task = gt; task < 64 * 2048; task += NT) {
        const int chain = task >> 11, vec = task & 2047, dir = chain >> 5, seq = (chain & 31) >> 2, hd = chain & 3;
        float stv[8];
#pragma unroll
        for (int j = 0; j < 8; ++j) stv[j] = 0.f;
        float m = -1e30f;
        for (int i = 0; i < 16; ++i) {
            const int cg = seq * 16 + (dir ? 15 - i : i), item = cg * 4 + hd;
            const float g = sc[dir * 1024 + item], ml = sc[2048 + dir * 1024 + item];
            const float mn = fmaxf(g + m, ml), a = __expf(g + m - mn), cc = __expf(ml - mn);
            u32x4* ptr = (u32x4*)(st + (size_t)(dir * 1024 + item) * 16384 + vec * 8);
            f32x4 x0, x1; unpack8(*ptr, x0, x1);
            const f32x4 o0 = {stv[0], stv[1], stv[2], stv[3]}, o1 = {stv[4], stv[5], stv[6], stv[7]};
            *ptr = pack8v(o0, o1);
#pragma unroll
            for (int j = 0; j < 4; ++j) { stv[j] = a * stv[j] + cc * x0[j]; stv[4 + j] = a * stv[4 + j] + cc * x1[j]; }
            m = mn;
        }
    }
    for (int task = gt; task < 8 * 16384; task += NT) {
        const int chain = task >> 14, el = task & 16383, dir = chain >> 2, hd = chain & 3;
        float s = 0.f, m = -1e30f;
        for (int i0 = 0; i0 < 128; i0 += 8) {
            bf16_t xv[8];
#pragma unroll
            for (int j = 0; j < 8; ++j) { const int i = i0 + j, cg = 128 + (dir ? 127 - i : i); xv[j] = st[(size_t)(dir * 1024 + cg * 4 + hd) * 16384 + el]; }
#pragma unroll
            for (int j = 0; j < 8; ++j) {
                const int i = i0 + j, cg = 128 + (dir ? 127 - i : i), item = cg * 4 + hd;
                const float g = sc[dir * 1024 + item], ml = sc[2048 + dir * 1024 + item];
                const float mn = fmaxf(g + m, ml), a = __expf(g + m - mn), cc = __expf(ml - mn);
                st[(size_t)(dir * 1024 + item) * 16384 + el] = (bf16_t)(pk2(s, 0.f) & 0xffffu);
                s = a * s + cc * __uint_as_float((unsigned)xv[j] << 16);
                m = mn;
            }
        }
    }
    for (int task = gt; task < 72 * 128; task += NT) {
        const int chain = task >> 7, k = task & 127;
        int dir, seq, hd, c0, nc;
        if (chain < 64) { dir = chain >> 5; seq = (chain & 31) >> 2; hd = chain & 3; c0 = seq * 16; nc = 16; }
        else { dir = (chain - 64) >> 2; hd = chain & 3; c0 = 128; nc = 128; }
        float s = 0.f, m = -1e30f;
        for (int i = 0; i < nc; ++i) {
            const int cg = c0 + (dir ? nc - 1 - i : i), item = cg * 4 + hd;
            const float g = sc[dir * 1024 + item], ml = sc[2048 + dir * 1024 + item];
            const float mn = fmaxf(g + m, ml), a = __expf(g + m - mn), cc = __expf(ml - mn);
            float* ptr = nl + (size_t)(dir * 1024 + item) * 128 + k;
            const float x = *ptr; *ptr = s;
            if (k == 0) mprev[dir * 1024 + item] = m;
            s = a * s + cc * x; m = mn;
        }
    }
}

DI void mout_item(int cg, int hd, int ts, unsigned char* ws, const float* mnorm_g, LAS float* wl, int lane) {
    const int tb = cg * 128, t0 = tb + ts * 32, c = lane & 31, hh = lane >> 5, item = cg * 4 + hd, tl = ts * 32 + c;
    const float* gates = (const float*)(ws + WS_GATES);
    const float* bf_ = (const float*)(ws + WS_BARR) + (size_t)hd * T + tb;
    const float* bb_ = (const float*)(ws + WS_BARR) + (size_t)(4 + hd) * T + tb;
    LDS_FENCE();
    wl[lane] = bf_[lane] - gates[(size_t)(tb + lane) * 16 + hd];
    wl[64 + lane] = bf_[64 + lane] - gates[(size_t)(tb + 64 + lane) * 16 + hd];
    wl[128 + lane] = bb_[lane] - gates[(size_t)(tb + lane) * 16 + 8 + hd];
    wl[192 + lane] = bb_[64 + lane] - gates[(size_t)(tb + 64 + lane) * 16 + 8 + hd];
    LDS_FENCE();
    const float bft = bf_[tl], bbt = bb_[tl];
    const float* mprev = (const float*)(ws + WS_SC) + 4096;
    const float mpf = mprev[item], mpb = mprev[1024 + item];
    bf16_t* mq = (bf16_t*)(ws + WS_NAT + 4 * MB_ARR); const bf16_t* mk = mq + (size_t)T * 512;
    const bf16_t* mvT = (const bf16_t*)(ws + WS_XT) + (size_t)640 * T + (size_t)(hd * 128) * T + tb;
    bf16x8 qf[8];
#pragma unroll
    for (int ks = 0; ks < 8; ++ks) qf[ks] = *(const bf16x8*)(mq + (size_t)(t0 + c) * 512 + hd * 128 + ks * 16 + hh * 8);
    const float DHS = 0.08838834764831845f;
    float mf = bft + mpf, mb = bbt + mpb;
#pragma unroll 1
    for (int blk = 0; blk < 8; ++blk) {
        const int sb = 64 * hh + 8 * blk;
        const f32x4 uf0 = *(const LAS f32x4*)(wl + sb), uf1 = *(const LAS f32x4*)(wl + sb + 4);
        const f32x4 ub0 = *(const LAS f32x4*)(wl + 128 + sb), ub1 = *(const LAS f32x4*)(wl + 128 + sb + 4);
#pragma unroll
        for (int j = 0; j < 8; ++j) {
            const int sl = sb + j; const float uf = j < 4 ? uf0[j & 3] : uf1[j & 3], ub = j < 4 ? ub0[j & 3] : ub1[j & 3];
            mf = fmaxf(mf, sl <= tl ? bft - uf : -INFINITY);
            mb = fmaxf(mb, sl >= tl ? bbt - ub : -INFINITY);
        }
    }
    mf = fmaxf(mf, __shfl_xor(mf, 32)); mb = fmaxf(mb, __shfl_xor(mb, 32));
    const int krow = swap23(c);
    float rsf = 0.f, rsb = 0.f;
    bf16x8 pf[4][2], pfd[2];
    pfd[0] = qf[0]; pfd[1] = qf[0];
#pragma unroll
    for (int stt = 0; stt < 4; ++stt) {
        f32x16 a;
#pragma unroll
        for (int v = 0; v < 16; ++v) a[v] = 0.f;
        const bf16_t* kp = mk + (size_t)(tb + 32 * stt + krow) * 512 + hd * 128 + hh * 8;
#pragma unroll
        for (int ks = 0; ks < 8; ++ks) { const bf16x8 kf = *(const bf16x8*)(kp + ks * 16); a = MFMA32(kf, qf[ks], a); }
        f32x16 pb;
#pragma unroll
        for (int v8 = 0; v8 < 2; ++v8) {
            const int sb = 32 * stt + 16 * v8 + 8 * hh;
            const f32x4 uf0 = *(const LAS f32x4*)(wl + sb), uf1 = *(const LAS f32x4*)(wl + sb + 4);
            const f32x4 ub0 = *(const LAS f32x4*)(wl + 128 + sb), ub1 = *(const LAS f32x4*)(wl + 128 + sb + 4);
#pragma unroll
            for (int j = 0; j < 8; ++j) {
                const int sl = sb + j; const float uf = j < 4 ? uf0[j & 3] : uf1[j & 3], ub = j < 4 ? ub0[j & 3] : ub1[j & 3];
                const float sv = a[8 * v8 + j] * DHS;
                if (stt < ts) { const float pv = __expf(bft - uf - mf) * sv; rsf += pv; a[8 * v8 + j] = pv; }
                else if (stt > ts) { const float pv = __expf(bbt - ub - mb) * sv; rsb += pv; a[8 * v8 + j] = pv; }
                else {
                    const float pv = sl <= tl ? __expf(bft - uf - mf) * sv : 0.f, pw = sl >= tl ? __expf(bbt - ub - mb) * sv : 0.f;
                    rsf += pv; rsb += pw; a[8 * v8 + j] = pv; pb[8 * v8 + j] = pw;
                }
            }
        }
        pf[stt][0] = pack8(a, 0); pf[stt][1] = pack8(a, 1);
        if (stt == ts) { pfd[0] = pack8(pb, 0); pfd[1] = pack8(pb, 1); }
    }
    rsf += __shfl_xor(rsf, 32); rsb += __shfl_xor(rsb, 32);
    const float* nf = (const float*)(ws + WS_NL) + (size_t)item * 128; const float* nb = nf + (size_t)1024 * 128;
    float nqf = 0.f, nqb = 0.f;
#pragma unroll
    for (int ks = 0; ks < 8; ++ks) {
        f32x4 q0, q1; unpack8(__builtin_bit_cast(u32x4, qf[ks]), q0, q1);
        const f32x4 a0 = *(const f32x4*)(nf + ks * 16 + hh * 8), a1 = *(const f32x4*)(nf + ks * 16 + hh * 8 + 4);
        const f32x4 c0 = *(const f32x4*)(nb + ks * 16 + hh * 8), c1 = *(const f32x4*)(nb + ks * 16 + hh * 8 + 4);
#pragma unroll
        for (int j = 0; j < 4; ++j) { nqf += q0[j] * a0[j] + q1[j] * a1[j]; nqb += q0[j] * c0[j] + q1[j] * c1[j]; }
    }
    nqf += __shfl_xor(nqf, 32); nqb += __shfl_xor(nqb, 32);
    const float af = __expf(bft + mpf - mf), ab = __expf(bbt + mpb - mb);
    const float denf = rsf + af * nqf, denb = rsb + ab * nqb;
    const float idf = 1.0f / fmaxf(fabsf(denf), __expf(-mf)), idb = 1.0f / fmaxf(fabsf(denb), __expf(-mb));
    const float cf = af * idf, cbk = ab * idb;
    const bf16_t* Cf = (const bf16_t*)(ws + WS_ST) + (size_t)item * 16384; const bf16_t* Cb = Cf + (size_t)1024 * 16384;
    float ss = 0.f;
    bf16_t* op = mq + (size_t)(t0 + c) * 512 + hd * 128 + 4 * hh;
#pragma unroll 1
    for (int dvt = 0; dvt < 4; ++dvt) {
        f32x16 aPf, aPb, aF, aB;
#pragma unroll
        for (int v = 0; v < 16; ++v) { aPf[v] = 0.f; aPb[v] = 0.f; aF[v] = 0.f; aB[v] = 0.f; }
        const bf16_t* vrow = mvT + (size_t)(dvt * 32 + c) * T + 8 * hh;
#pragma unroll
        for (int stt = 0; stt < 4; ++stt)
#pragma unroll
            for (int s2 = 0; s2 < 2; ++s2) {
                const bf16x8 vf = *(const bf16x8*)(vrow + 32 * stt + 16 * s2);
                if (stt < ts) aPf = MFMA32(vf, pf[stt][s2], aPf);
                else if (stt > ts) aPb = MFMA32(vf, pf[stt][s2], aPb);
                else { aPf = MFMA32(vf, pf[stt][s2], aPf); aPb = MFMA32(vf, pfd[s2], aPb); }
            }
        const bf16_t* cfrow = Cf + (size_t)(dvt * 32 + c) * 128 + 8 * hh; const bf16_t* cbrow = Cb + (size_t)(dvt * 32 + c) * 128 + 8 * hh;
#pragma unroll
        for (int ks = 0; ks < 8; ++ks) {
            const bf16x8 c1 = *(const bf16x8*)(cfrow + 16 * ks);
            const bf16x8 c2 = *(const bf16x8*)(cbrow + 16 * ks);
            aF = MFMA32(c1, qf[ks], aF); aB = MFMA32(c2, qf[ks], aB);
        }
#pragma unroll
        for (int gq = 0; gq < 4; ++gq) {
            float hv[4];
#pragma unroll
            for (int j = 0; j < 4; ++j) { const int v = 4 * gq + j; hv[j] = idf * aPf[v] + idb * aPb[v] + cf * aF[v] + cbk * aB[v]; ss += hv[j] * hv[j]; }
            u32x2 w; w.x = pk2(hv[0], hv[1]); w.y = pk2(hv[2], hv[3]);
            *(u32x2*)(op + dvt * 32 + 8 * gq) = w;
        }
    }
    ss += __shfl_xor(ss, 32);
    const float rn = __builtin_amdgcn_rsqf(ss * (1.0f / 128.0f) + EPS);
    const float* mg = mnorm_g + hd * 128 + 4 * hh;
#pragma unroll 1
    for (int dvt = 0; dvt < 4; ++dvt)
#pragma unroll
        for (int gq = 0; gq < 4; ++gq) {
            const f32x4 gg = *(const f32x4*)(mg + dvt * 32 + 8 * gq);
            u32x2* ptr = (u32x2*)(op + dvt * 32 + 8 * gq);
            const u32x2 hw = *ptr;
            u32x2 w; w.x = pk2(bflo(hw.x) * rn * gg[0], bfhi(hw.x) * rn * gg[1]); w.y = pk2(bflo(hw.y) * rn * gg[2], bfhi(hw.y) * rn * gg[3]);
            *ptr = w;
        }
    LDS_FENCE();
}

DI void phase_mout(const Params& p, int l, LAS unsigned char* lds) {
    const int tid0 = otid(), lane = tid0 & 63, wid = tid0 >> 6, gw = obid() * 8 + wid, NW = gridDim.x * 8;
    LAS float* wl = (LAS float*)(lds + wid * 4096);
    for (int it = gw; it < 4096; it += NW) mout_item(it >> 4, (it >> 2) & 3, it & 3, p.ws, p.in[6] + l * 512, wl, lane);
}

DI void phase_final(const Params& p) {
    const float* ssq = (const float*)(p.ws + WS_SSQ) + 4 * T; const float* g = p.in[15];
    for (int i = obid() * 512 + otid(); i < T * 256; i += gridDim.x * 512) {
        const int row = i >> 8, c4 = (i & 255) * 4;
        const float r = __builtin_amdgcn_rsqf(ssq[row] * (1.0f / 1024.0f) + EPS);
        f32x4 v = *(f32x4*)(p.out + (size_t)row * D + c4); const f32x4 gg = *(const f32x4*)(g + c4);
        v = v * r * gg;
        *(f32x4*)(p.out + (size_t)row * D + c4) = v;
    }
}

DI pg8::Order make_order(const void* A, int nM, const void* B, int nN, int K) {
    pg8::Order o; o.nM0 = nM; o.nN0 = nN; o.n0 = nM * nN; o.nM1 = 0; o.nN1 = 0; o.n1 = 0; o.G = gridDim.x; o.c = obid();
    o.A0 = (const char*)A; o.B0 = (const char*)B; o.A1 = nullptr; o.B1 = nullptr; o.tstep = (size_t)256 * K * 2; return o;
}

__global__ void __launch_bounds__(512, 2) fwd_megakernel(Params p) {
    extern __shared__ __attribute__((aligned(16))) unsigned char lds_raw[];
    LAS unsigned char* lds = (LAS unsigned char*)lds_raw;
    cg::grid_group grid = cg::this_grid();
    unsigned char* ws = p.ws;
    bf16_t* xb = (bf16_t*)(ws + WS_XB); float* ssq = (float*)(ws + WS_SSQ);

#ifndef SKIP_PREP
    phase_prep(p, lds);
#endif
    grid.sync();
    for (int l = 0; l < 2; ++l) {
        unsigned char* wb = ws + WS_W + (size_t)l * LW_SIZE;
        {
            pg8::Order o = make_order(xb, 128, wb + LW_W1A, 13, 1024);
            o.nM1 = 5; o.nN1 = 128; o.n1 = 640; o.A1 = (const char*)(wb + LW_W1B); o.B1 = (const char*)xb;
            EpiP1 e{ws, ssq + (size_t)(2 * l) * T, p.in[5] + l * 16};
#ifndef SKIP_P1
            pg8::gemm_phase(lds, 1024, o, e);
#endif
        }
        grid.sync();
#ifndef SKIP_MIX
        phase_mix(p, l, lds);
#endif
        grid.sync();
#ifndef SKIP_SCAN
        phase_scan(p);
#endif
        grid.sync();
#ifndef SKIP_MOUT
        phase_mout(p, l, lds);
#endif
        grid.sync();
        {
            pg8::Order o = make_order(xb, 128, wb + LW_WG, 14, 1024);
            EpiGates e{ws, ssq + (size_t)(2 * l) * T};
            pg8::gemm_phase(lds, 1024, o, e);
        }
        grid.sync();
        { pg8::Order o = make_order(ws + WS_NAT, 128, wb + LW_WA, 4, 512); EpiY<0> e{ws}; pg8::gemm_phase(lds, 512, o, e); }
        grid.sync();
        { pg8::Order o = make_order(ws + WS_NAT + 3 * MB_ARR, 128, wb + LW_WB, 4, 512); EpiY<1> e{ws}; pg8::gemm_phase(lds, 512, o, e); }
        grid.sync();
        { pg8::Order o = make_order(ws + WS_NAT + 4 * MB_ARR, 128, wb + LW_WC, 4, 512); EpiY<2> e{ws}; pg8::gemm_phase(lds, 512, o, e); }
        grid.sync();
        {
            pg8::Order o = make_order(ws + WS_SIG0, 128, wb + LW_WO, 4, 1024);
            EpiRes e{p.in[0], p.in[1], p.out, xb, ssq + (size_t)(2 * l + 1) * T, l == 0};
            pg8::gemm_phase(lds, 1024, o, e);
        }
        grid.sync();
        {
            pg8::Order o = make_order(xb, 128, wb + LW_WUP, 16, 1024);
            EpiUp e{(bf16_t*)(ws + WS_HID), ssq + (size_t)(2 * l + 1) * T};
            pg8::gemm_phase(lds, 1024, o, e);
        }
        grid.sync();
        {
            pg8::Order o = make_order(ws + WS_HID, 128, wb + LW_WDN, 4, 4096);
            EpiRes e{p.in[0], p.in[1], p.out, xb, ssq + (size_t)(2 * l + 2) * T, 0};
            pg8::gemm_phase(lds, 4096, o, e);
        }
        grid.sync();
    }
    phase_final(p);
}

extern "C" void kernel_launch(void* const* d_in, const int* in_sizes, int n_in, void* d_out, int out_size, void* d_ws, size_t ws_size, hipStream_t stream) {
    static int grid_blocks = 0;
    if (grid_blocks == 0) {
        if (n_in != 16 || out_size != T * D || ws_size < WS_END) { fprintf(stderr, "kernel_launch: unexpected shapes (n_in %d out %d ws %zu need %zu)\n", n_in, out_size, ws_size, (size_t)WS_END); grid_blocks = -1; return; }
        int dev = 0, cus = 0, per_cu = 0;
        hipGetDevice(&dev);
        hipDeviceGetAttribute(&cus, hipDeviceAttributeMultiprocessorCount, dev);
        hipFuncSetAttribute((const void*)fwd_megakernel, hipFuncAttributeMaxDynamicSharedMemorySize, pg8::STAGE_BYTES);
        hipOccupancyMaxActiveBlocksPerMultiprocessor(&per_cu, (const void*)fwd_megakernel, 512, pg8::STAGE_BYTES);
        if (per_cu < 1) per_cu = 1;
        grid_blocks = cus;
        (void)hipGetLastError();
    }
    if (grid_blocks < 0) return;
    Params p{};
    for (int i = 0; i < 16; ++i) p.in[i] = (const float*)d_in[i];
    p.out = (float*)d_out; p.ws = (unsigned char*)d_ws;
    void* args[] = {&p};
    hipError_t e = hipLaunchCooperativeKernel((const void*)fwd_megakernel, dim3(grid_blocks), dim3(512), args, pg8::STAGE_BYTES, stream);
    if (e != hipSuccess) fprintf(stderr, "cooperative launch failed: %s (grid %d)\n", hipGetErrorString(e), grid_blocks);
}
```

```cpp
#include <hip/hip_runtime.h>
#include <hip/hip_cooperative_groups.h>
#include <cstdio>
namespace cg = cooperative_groups;

#define LAS __attribute__((address_space(3)))
typedef unsigned short bf16_t;
typedef short bf16x8 __attribute__((ext_vector_type(8)));
typedef float f32x4 __attribute__((ext_vector_type(4)));
typedef float f32x2 __attribute__((ext_vector_type(2)));
typedef float f32x16 __attribute__((ext_vector_type(16)));
typedef unsigned u32x4 __attribute__((ext_vector_type(4)));
typedef unsigned u32x2 __attribute__((ext_vector_type(2)));
typedef __bf16 bf16x2v __attribute__((ext_vector_type(2)));
#define DI __device__ __forceinline__
#define MFMA32(a, b, c) __builtin_amdgcn_mfma_f32_32x32x16_bf16((a), (b), (c), 0, 0, 0)

constexpr int T = 32768, D = 1024, NIN = 7440, TP = 16384;
constexpr float EPS = 1e-6f;
constexpr size_t MB_ARR = (size_t)T * 512 * 2;

constexpr size_t LW_W1A = 0;
constexpr size_t LW_W1B = LW_W1A + (size_t)3328 * 1024 * 2;
constexpr size_t LW_WG  = LW_W1B + (size_t)1280 * 1024 * 2;
constexpr size_t LW_WA  = LW_WG + (size_t)3584 * 1024 * 2;
constexpr size_t LW_WB  = LW_WA + (size_t)1024 * 512 * 2;
constexpr size_t LW_WC  = LW_WB + (size_t)1024 * 512 * 2;
constexpr size_t LW_WO  = LW_WC + (size_t)1024 * 512 * 2;
constexpr size_t LW_WUP = LW_WO + (size_t)1024 * 1024 * 2;
constexpr size_t LW_WDN = LW_WUP + (size_t)4096 * 1024 * 2;
constexpr size_t LW_SIZE = LW_WDN + (size_t)4096 * 1024 * 2;

constexpr size_t WS_W   = 0;
constexpr size_t WS_XB  = WS_W + 2 * LW_SIZE;
constexpr size_t WS_NAT = WS_XB + (size_t)T * 1024 * 2;
constexpr size_t WS_AK  = WS_NAT + 6 * MB_ARR;
constexpr size_t WS_XT  = WS_AK + (size_t)T * 128 * 2;
constexpr size_t WS_ST  = WS_XT + (size_t)1152 * T * 2;
constexpr size_t WS_GATES = WS_ST + (size_t)2 * 1024 * 16384 * 2;
constexpr size_t WS_BARR = WS_GATES + (size_t)T * 16 * 4;
constexpr size_t WS_NL  = WS_BARR + (size_t)8 * T * 4;
constexpr size_t WS_SC  = WS_NL + (size_t)2 * 1024 * 128 * 4;
constexpr size_t WS_SSQ = WS_SC + (size_t)3 * 2048 * 4;
constexpr size_t WS_NP  = WS_SSQ + (size_t)5 * T * 4;
constexpr size_t WS_RN  = WS_NP + (size_t)2 * 1024 * 128 * 4;
constexpr size_t WS_END = WS_RN + (size_t)T * 4 * 4;
constexpr size_t WS_HID = WS_NAT;
constexpr size_t WS_SIG0 = WS_NAT + MB_ARR;
constexpr size_t WS_SIG1 = WS_XT;
constexpr size_t WS_SIG2 = WS_ST;

#define TPROBE 0
#define TP_PREP 0
#define TP_GROUP 1
struct Params { const float* in[16]; float* out; unsigned char* ws; };

DI int otid() { int t = threadIdx.x; asm volatile("" : "+v"(t)); return t; }
DI int obid() { int b = blockIdx.x; asm volatile("" : "+s"(b)); return b; }
DI unsigned pk2(float a, float b) { f32x2 v = {a, b}; bf16x2v r = __builtin_convertvector(v, bf16x2v); return __builtin_bit_cast(unsigned, r); }
DI float bflo(unsigned u) { return __uint_as_float(u << 16); }
DI float bfhi(unsigned u) { return __uint_as_float(u & 0xffff0000u); }
DI float sigmoidf_(float x) { return 1.0f / (1.0f + __expf(-x)); }
DI size_t xt_off(int xr, int tok) { return ((size_t)(tok >> 5) * 1152 + xr) * 32 + (tok & 31); }
DI int swap23(int c) { return (c & ~12) | ((c & 4) << 1) | ((c & 8) >> 1); }
DI bf16x8 pack8(const f32x16& x, int s) {
    u32x4 p;
    if (s == 0) { p.x = pk2(x[0], x[1]); p.y = pk2(x[2], x[3]); p.z = pk2(x[4], x[5]); p.w = pk2(x[6], x[7]); }
    else { p.x = pk2(x[8], x[9]); p.y = pk2(x[10], x[11]); p.z = pk2(x[12], x[13]); p.w = pk2(x[14], x[15]); }
    return __builtin_bit_cast(bf16x8, p);
}

namespace pg8 {
constexpr int BM = 256, BK = 64, HALF = 128, HTB = HALF * BK * 2, STAGE_BYTES = 8 * HTB, NXCD = 8, WGM = 8;
DI int lds_byte(int r, int c) { const int st = (r >> 4) * 2 + (c >> 5), rr = r & 15, cc = c & 31, ob = rr * 64 + cc * 2; return st * 1024 + (ob ^ (((ob >> 9) & 1) << 5)); }
DI void stage_rc(int b, int& R, int& C) { const int st = b / 1024, sb = b % 1024, swz = sb ^ (((sb >> 9) & 1) << 5); R = (st >> 1) * 16 + swz / 64; C = (st & 1) * 32 + (swz % 64) / 2; }
DI int perm32(int rho) { const int n = rho >> 4, i = rho & 15; return 8 * (i >> 2) + 4 * n + (i & 3); }

struct Unit { int pm, pn, kind; const char* A; const char* Bt; };

struct Order {
    int nM0, nN0, n0, nM1, nN1, n1, G, c;
    const char *A0, *B0, *A1, *B1; size_t tstep;
    DI void map(int wgid, int nwg, int nM, int nN, int& pm, int& pn) const {
        { const int q = nwg / NXCD, r = nwg % NXCD, xcd = wgid % NXCD, off = wgid / NXCD; wgid = (xcd < r ? xcd * (q + 1) : r * (q + 1) + (xcd - r) * q) + off; }
        const int nig = WGM * nN, gid = wgid / nig, fm = gid * WGM, gsz = (nM - fm) < WGM ? (nM - fm) : WGM;
        pm = fm + ((wgid % nig) % gsz); pn = (wgid % nig) / gsz;
    }
    DI bool next(int i, Unit& u) const {
        const int L = i * G + c; if (L >= n0 + n1) return false;
        int pm, pn;
        if (L < n0) { map(L, n0, nM0, nN0, pm, pn); u.kind = 0; u.A = A0 + (size_t)pm * tstep; u.Bt = B0 + (size_t)pn * tstep; }
        else { map(L - n0, n1, nM1, nN1, pm, pn); u.kind = 1; u.A = A1 + (size_t)pm * tstep; u.Bt = B1 + (size_t)pn * tstep; }
        u.pm = pm; u.pn = pn; return true;
    }
};

template <class Epi>
DI void gemm_phase(LAS unsigned char* lds, const int K, const Order& S, const Epi& E) {
    const int tid = otid(), wid = __builtin_amdgcn_readfirstlane(tid >> 6), lane = tid & 63, wr = wid >> 2, wc = wid & 3, fr = lane & 15, fq = lane >> 4;
    const int nt = K / BK;
    unsigned voffA[2], voffB[2];
#pragma unroll
    for (int i = 0; i < 2; ++i) { int R, C; stage_rc(tid * 16 + i * 8192, R, C); const int Rb = (R & ~31) + perm32(R & 31);
        voffA[i] = (unsigned)(R * K + C) * 2u; voffB[i] = (unsigned)(Rb * K + C) * 2u; }
    const size_t kstep = (size_t)(BK * 2);
    const size_t hstep = (size_t)HALF * K * 2;
    const unsigned ldsw = (unsigned)wid * 1024u;
    const int aoff = lds_byte(wr * 64 + fr, fq * 8), boff = lds_byte(wc * 32 + fr, fq * 8);
#define PG8_SA(b, h) (((b) * 2 + (h)) * HTB)
#define PG8_SB(b, h) ((4 + (b) * 2 + (h)) * HTB)
#define PG8_STAGE(bufoff, gbase, voff) do { _Pragma("unroll") for (int _i = 0; _i < 2; ++_i) \
        __builtin_amdgcn_global_load_lds((const unsigned*)((const char*)(gbase) + (voff)[_i]), (LAS unsigned*)(lds + (bufoff) + ldsw + _i * 8192), 16, 0, 0); } while (0)
#define PG8_LDA(dst, b, h) do { _Pragma("unroll") for (int m = 0; m < 4; ++m) _Pragma("unroll") for (int k = 0; k < 2; ++k) dst[m][k] = *(const LAS bf16x8*)(lds + PG8_SA(b, h) + aoff + m * 2048 + k * 1024); } while (0)
#define PG8_LDB(dst, b, h) do { _Pragma("unroll") for (int n = 0; n < 2; ++n) _Pragma("unroll") for (int k = 0; k < 2; ++k) dst[n][k] = *(const LAS bf16x8*)(lds + PG8_SB(b, h) + boff + n * 2048 + k * 1024); } while (0)
#define PG8_MMA(ai, bj, At, Bt) do { __builtin_amdgcn_s_setprio(1); _Pragma("unroll") for (int m = 0; m < 4; ++m) _Pragma("unroll") for (int n = 0; n < 2; ++n) _Pragma("unroll") for (int k = 0; k < 2; ++k) \
        acc[ai][bj][m][n] = __builtin_amdgcn_mfma_f32_16x16x32_bf16(Bt[n][k], At[m][k], acc[ai][bj][m][n], 0, 0, 0); __builtin_amdgcn_s_setprio(0); } while (0)
#define PG8_WAIT_V(n) asm volatile("s_waitcnt vmcnt(" #n ")" ::: "memory")
#define PG8_WAIT_L(n) asm volatile("s_waitcnt lgkmcnt(" #n ")" ::: "memory")
#define PG8_BAR __builtin_amdgcn_s_barrier()
#define PG8_SCHED __builtin_amdgcn_sched_barrier(0)
    Unit cur, nxt; int ui = 0;
    if (!S.next(0, cur)) return;
    f32x4 acc[2][2][4][2];
#pragma unroll
    for (int a = 0; a < 2; ++a)
#pragma unroll
        for (int b = 0; b < 2; ++b)
#pragma unroll
            for (int m = 0; m < 4; ++m)
#pragma unroll
                for (int n = 0; n < 2; ++n) acc[a][b][m][n] = (f32x4){0.f, 0.f, 0.f, 0.f};
    bf16x8 At[4][2], B0[2][2], B1[2][2];
    const char* cA = cur.A; const char* cB = cur.Bt;
    PG8_STAGE(PG8_SB(0, 0), cB, voffB); PG8_STAGE(PG8_SA(0, 0), cA, voffA); PG8_STAGE(PG8_SB(0, 1), cB + hstep, voffB); PG8_STAGE(PG8_SA(0, 1), cA + hstep, voffA);
    if (wr == 1) PG8_BAR;
    PG8_WAIT_V(4); PG8_BAR;
    PG8_STAGE(PG8_SB(1, 0), cB + kstep, voffB); PG8_STAGE(PG8_SA(1, 0), cA + kstep, voffA); PG8_STAGE(PG8_SB(1, 1), cB + hstep + kstep, voffB);
    PG8_WAIT_V(6); PG8_BAR;
    for (;;) {
        const bool has_next = S.next(ui + 1, nxt);
        const char* nA = has_next ? nxt.A : cA; const char* nB = has_next ? nxt.Bt : cB;
        for (int t = 0; t < nt; t += 2) {
            const bool last = (t == nt - 2);
            const char* a1 = cA + (size_t)(t + 1) * kstep;
            const char* a2 = last ? nA : cA + (size_t)(t + 2) * kstep; const char* b2 = last ? nB : cB + (size_t)(t + 2) * kstep;
            const char* a3 = a2 + kstep; const char* b3 = b2 + kstep;
            PG8_LDB(B0, 0, 0); PG8_SCHED; PG8_LDA(At, 0, 0); PG8_STAGE(PG8_SA(1, 1), a1 + hstep, voffA);
            PG8_WAIT_L(8); PG8_BAR; PG8_WAIT_L(0); PG8_MMA(0, 0, At, B0); PG8_BAR; PG8_SCHED;
            PG8_LDB(B1, 0, 1); PG8_STAGE(PG8_SB(0, 0), b2, voffB);
            PG8_BAR; PG8_WAIT_L(0); PG8_MMA(0, 1, At, B1); PG8_BAR;
            PG8_LDA(At, 0, 1); PG8_STAGE(PG8_SA(0, 0), a2, voffA);
            PG8_BAR; PG8_WAIT_L(0); PG8_MMA(1, 0, At, B0); PG8_BAR; PG8_SCHED;
            PG8_STAGE(PG8_SB(0, 1), b2 + hstep, voffB);
            PG8_WAIT_V(6); PG8_BAR; PG8_MMA(1, 1, At, B1); PG8_BAR;
            PG8_LDB(B0, 1, 0); PG8_SCHED; PG8_LDA(At, 1, 0); PG8_STAGE(PG8_SA(0, 1), a2 + hstep, voffA);
            PG8_WAIT_L(8); PG8_BAR; PG8_WAIT_L(0); PG8_MMA(0, 0, At, B0); PG8_BAR; PG8_SCHED;
            PG8_LDB(B1, 1, 1); PG8_STAGE(PG8_SB(1, 0), b3, voffB);
            PG8_BAR; PG8_WAIT_L(0); PG8_MMA(0, 1, At, B1); PG8_BAR;
            PG8_LDA(At, 1, 1); PG8_STAGE(PG8_SA(1, 0), a3, voffA);
            PG8_BAR; PG8_WAIT_L(0); PG8_MMA(1, 0, At, B0); PG8_BAR; PG8_SCHED;
            PG8_STAGE(PG8_SB(1, 1), b3 + hstep, voffB);
            PG8_WAIT_V(6); PG8_BAR; PG8_MMA(1, 1, At, B1); PG8_BAR;
        }
        E(acc, cur, wr, wc, fr, fq);
        if (!has_next) break;
#pragma unroll
        for (int a = 0; a < 2; ++a)
#pragma unroll
            for (int b = 0; b < 2; ++b)
#pragma unroll
                for (int m = 0; m < 4; ++m)
#pragma unroll
                    for (int n = 0; n < 2; ++n) acc[a][b][m][n] = (f32x4){0.f, 0.f, 0.f, 0.f};
        cur = nxt; cA = nA; cB = nB; ++ui;
    }
    PG8_WAIT_V(0);
    if (wr == 0) PG8_BAR;
    PG8_BAR;
#undef PG8_SA
#undef PG8_SB
#undef PG8_STAGE
#undef PG8_LDA
#undef PG8_LDB
#undef PG8_MMA
#undef PG8_WAIT_V
#undef PG8_WAIT_L
#undef PG8_BAR
#undef PG8_SCHED
}
}
using pg8::Unit;
typedef f32x4 AccT[2][2][4][2];

DI u32x4 pack8v(f32x4 v0, f32x4 v1) { u32x4 w; w.x = pk2(v0[0], v0[1]); w.y = pk2(v0[2], v0[3]); w.z = pk2(v1[0], v1[1]); w.w = pk2(v1[2], v1[3]); return w; }
DI void unpack8(u32x4 w, f32x4& v0, f32x4& v1) { v0 = (f32x4){bflo(w.x), bfhi(w.x), bflo(w.y), bfhi(w.y)}; v1 = (f32x4){bflo(w.z), bfhi(w.z), bflo(w.w), bfhi(w.w)}; }

struct EpiP1 {
    unsigned char* ws; const float* ssq; const float* gate_b;
    DI void operator()(const AccT& acc, const Unit& u, int wr, int wc, int fr, int fq) const {
        if (u.kind == 0) {
            const int pn = u.pn, row0 = u.pm * 256 + wr * 64 + fr, colt = wc * 32 + fq * 8;
            bf16_t* ak = (bf16_t*)(ws + WS_AK); float* gates = (float*)(ws + WS_GATES);
            const int arr = pn < 8 ? (pn >> 1) : 4 + ((pn - 9) >> 1), half = pn < 8 ? (pn & 1) : ((pn - 9) & 1);
            bf16_t* nat = (bf16_t*)(ws + WS_NAT) + (size_t)arr * T * 512 + half * 256 + colt;
#pragma unroll
            for (int ai = 0; ai < 2; ++ai)
#pragma unroll
                for (int m = 0; m < 4; ++m) {
                    const int row = row0 + ai * 128 + m * 16;
                    const float r = __builtin_amdgcn_rsqf(ssq[row] * (1.0f / 1024.0f) + EPS);
#pragma unroll
                    for (int bj = 0; bj < 2; ++bj) {
                        const f32x4 v0 = acc[ai][bj][m][0] * r, v1 = acc[ai][bj][m][1] * r;
                        if (pn != 8) { *(u32x4*)(nat + (size_t)row * 512 + bj * 128) = pack8v(v0, v1); }
                        else if (bj == 0) { *(u32x4*)(ak + (size_t)row * 128 + colt) = pack8v(v0, v1); }
                        else if (wc == 0 && fq < 2) {
                            const f32x4 b0 = *(const f32x4*)(gate_b + fq * 8), b1 = *(const f32x4*)(gate_b + fq * 8 + 4);
                            *(f32x4*)(gates + (size_t)row * 16 + fq * 8) = v0 + b0; *(f32x4*)(gates + (size_t)row * 16 + fq * 8 + 4) = v1 + b1;
                        }
                    }
                }
        } else {
            bf16_t* xt = (bf16_t*)(ws + WS_XT);
            const int tok0 = u.pn * 256 + wc * 32 + fq * 8, f0 = u.pm * 256 + wr * 64 + fr;
            f32x4 rs[2][2];
#pragma unroll
            for (int bj = 0; bj < 2; ++bj)
#pragma unroll
                for (int n = 0; n < 2; ++n) { const f32x4 s = *(const f32x4*)(ssq + tok0 + bj * 128 + n * 4);
#pragma unroll
                    for (int j = 0; j < 4; ++j) rs[bj][n][j] = __builtin_amdgcn_rsqf(s[j] * (1.0f / 1024.0f) + EPS); }
#pragma unroll
            for (int ai = 0; ai < 2; ++ai) {
                if (u.pm == 0 && ai == 1) continue;
#pragma unroll
                for (int m = 0; m < 4; ++m) {
                    const int f = f0 + ai * 128 + m * 16; const int xr = f < 128 ? f : f - 128;
#pragma unroll
                    for (int bj = 0; bj < 2; ++bj)
                        *(u32x4*)(xt + xt_off(xr, tok0 + bj * 128)) = pack8v(acc[ai][bj][m][0] * rs[bj][0], acc[ai][bj][m][1] * rs[bj][1]);
                }
            }
        }
    }
};

struct EpiGates {
    unsigned char* ws; const float* ssq; const float* mnorm_g;
    DI void operator()(const AccT& acc, const Unit& u, int wr, int wc, int fr, int fq) const {
        const int pn = u.pn, row0 = u.pm * 256 + wr * 64 + fr, colt = wc * 32 + fq * 8;
        bf16_t* dst; int ld;
        if (pn < 12) { const int br = pn >> 2; dst = (bf16_t*)(ws + (br == 0 ? WS_SIG0 : (br == 1 ? WS_SIG1 : WS_SIG2))) + (pn & 3) * 256 + colt; ld = 1024; }
        else { dst = (bf16_t*)(ws + WS_NAT + 4 * MB_ARR) + (pn - 12) * 256 + colt; ld = 512; }
#pragma unroll
        for (int ai = 0; ai < 2; ++ai)
#pragma unroll
            for (int m = 0; m < 4; ++m) {
                const int row = row0 + ai * 128 + m * 16;
                const float r = __builtin_amdgcn_rsqf(ssq[row] * (1.0f / 1024.0f) + EPS);
#pragma unroll
                for (int bj = 0; bj < 2; ++bj) {
                    f32x4 v0 = acc[ai][bj][m][0] * r, v1 = acc[ai][bj][m][1] * r;
#pragma unroll
                    for (int j = 0; j < 4; ++j) { v0[j] = sigmoidf_(v0[j]); v1[j] = sigmoidf_(v1[j]); }
                    u32x4* p = (u32x4*)(dst + (size_t)row * ld + bj * 128);
                    if (pn >= 12) {
                        const int mcol = (pn - 12) * 256 + colt + bj * 128;
                        const float rnv = ((const float*)(ws + WS_RN))[(size_t)row * 4 + (mcol >> 7)];
                        const f32x4 g0 = *(const f32x4*)(mnorm_g + mcol) * rnv, g1 = *(const f32x4*)(mnorm_g + mcol + 4) * rnv;
                        f32x4 h0, h1; unpack8(*p, h0, h1); v0 *= h0 * g0; v1 *= h1 * g1;
                    }
                    *p = pack8v(v0, v1);
                }
            }
    }
};

template <int BR> struct EpiY {
    unsigned char* ws;
    DI void operator()(const AccT& acc, const Unit& u, int wr, int wc, int fr, int fq) const {
        const int row0 = u.pm * 256 + wr * 64 + fr, col = u.pn * 256 + wc * 32 + fq * 8;
        bf16_t* mg = (bf16_t*)(ws + WS_SIG0) + col;
        const bf16_t* sg = (const bf16_t*)(ws + (BR == 0 ? WS_SIG0 : (BR == 1 ? WS_SIG1 : WS_SIG2))) + col;
#pragma unroll
        for (int ai = 0; ai < 2; ++ai)
#pragma unroll
            for (int m = 0; m < 4; ++m) {
                const int row = row0 + ai * 128 + m * 16;
#pragma unroll
                for (int bj = 0; bj < 2; ++bj) {
                    f32x4 g0, g1; unpack8(*(const u32x4*)(sg + (size_t)row * 1024 + bj * 128), g0, g1);
                    f32x4 v0 = acc[ai][bj][m][0] * g0, v1 = acc[ai][bj][m][1] * g1;
                    u32x4* p = (u32x4*)(mg + (size_t)row * 1024 + bj * 128);
                    if (BR > 0) { f32x4 o0, o1; unpack8(*p, o0, o1); v0 += o0; v1 += o1; }
                    *p = pack8v(v0, v1);
                }
            }
    }
};

struct EpiRes {
    const float* x0; const float* x1; float* out; bf16_t* xb; float* ssq_next; int first;
    DI void operator()(const AccT& acc, const Unit& u, int wr, int wc, int fr, int fq) const {
        const int row0 = u.pm * 256 + wr * 64 + fr, col = u.pn * 256 + wc * 32 + fq * 8;
#pragma unroll
        for (int ai = 0; ai < 2; ++ai)
#pragma unroll
            for (int m = 0; m < 4; ++m) {
                const int row = row0 + ai * 128 + m * 16;
                const float* xs = first ? (row < TP ? x0 + (size_t)row * D : x1 + (size_t)(row - TP) * D) : out + (size_t)row * D;
                float s = 0.f;
#pragma unroll
                for (int bj = 0; bj < 2; ++bj) {
                    const f32x4 a0 = *(const f32x4*)(xs + col + bj * 128), a1 = *(const f32x4*)(xs + col + bj * 128 + 4);
                    const f32x4 v0 = acc[ai][bj][m][0] + a0, v1 = acc[ai][bj][m][1] + a1;
                    *(f32x4*)(out + (size_t)row * D + col + bj * 128) = v0; *(f32x4*)(out + (size_t)row * D + col + bj * 128 + 4) = v1;
                    *(u32x4*)(xb + (size_t)row * D + col + bj * 128) = pack8v(v0, v1);
#pragma unroll
                    for (int j = 0; j < 4; ++j) s += v0[j] * v0[j] + v1[j] * v1[j];
                }
                s += __shfl_xor(s, 16); s += __shfl_xor(s, 32);
                if (fq == 0) atomicAdd(ssq_next + row, s);
            }
    }
};

struct EpiUp {
    bf16_t* hid; const float* ssq;
    DI void operator()(const AccT& acc, const Unit& u, int wr, int wc, int fr, int fq) const {
        const int row0 = u.pm * 256 + wr * 64 + fr, col = u.pn * 256 + wc * 32 + fq * 8;
#pragma unroll
        for (int ai = 0; ai < 2; ++ai)
#pragma unroll
            for (int m = 0; m < 4; ++m) {
                const int row = row0 + ai * 128 + m * 16;
                const float r = __builtin_amdgcn_rsqf(ssq[row] * (1.0f / 1024.0f) + EPS);
#pragma unroll
                for (int bj = 0; bj < 2; ++bj) {
                    f32x4 v0 = acc[ai][bj][m][0] * r, v1 = acc[ai][bj][m][1] * r;
#pragma unroll
                    for (int j = 0; j < 4; ++j) { const float a = fmaxf(v0[j], 0.f), b = fmaxf(v1[j], 0.f); v0[j] = a * a; v1[j] = b * b; }
                    *(u32x4*)(hid + (size_t)row * 4096 + col + bj * 128) = pack8v(v0, v1);
                }
            }
    }
};

DI void prep_seg(LAS float* tile, bf16_t* dst, int drow0, int nrows, const float* src, int ld, int col0, int valid, int K, const float* g, int rot) {
    const int ntn = nrows / 64, ntk = K / 64, tid = otid(), nb = gridDim.x;
    for (int t = (obid() + nb - (rot % nb)) % nb; t < ntn * ntk; t += nb) {
        const int tn = t % ntn, tk = t / ntn;
#pragma unroll
        for (int i = 0; i < 8; ++i) {
            const int e = tid + 512 * i, kr = e >> 6, nc = e & 63, n = tn * 64 + nc, k = tk * 64 + kr;
            float v = 0.f;
            if (n < valid) { v = src[(size_t)k * ld + col0 + n]; if (g) v *= g[k]; }
            tile[kr * 65 + nc] = v;
        }
        __syncthreads();
#pragma unroll
        for (int i = 0; i < 4; ++i) {
            const int e = tid + 512 * i, nr = e >> 5, kp = e & 31;
            *(unsigned*)(dst + (size_t)(drow0 + tn * 64 + nr) * K + tk * 64 + 2 * kp) = pk2(tile[(2 * kp) * 65 + nr], tile[(2 * kp + 1) * 65 + nr]);
        }
        __syncthreads();
    }
}

DI void phase_prep(const Params& p, LAS unsigned char* lds) {
    LAS float* tile = (LAS float*)lds;
    int rot = 0;
    for (int l = 0; l < 2; ++l) {
        unsigned char* wb = p.ws + WS_W + (size_t)l * LW_SIZE;
        const float* win = p.in[2] + (size_t)l * D * NIN; const float* gmix = p.in[11] + l * D; const float* gmlp = p.in[12] + l * D;
        bf16_t* w1a = (bf16_t*)(wb + LW_W1A); bf16_t* w1b = (bf16_t*)(wb + LW_W1B); bf16_t* wg = (bf16_t*)(wb + LW_WG);
        prep_seg(tile, w1a, 0, 2048, win, NIN, 0, 2048, 1024, gmix, rot); rot += 512;
        prep_seg(tile, w1a, 2048, 128, win, NIN, 2048, 128, 1024, gmix, rot); rot += 32;
        prep_seg(tile, w1a, 2176, 128, win, NIN, 4352, 16, 1024, gmix, rot); rot += 32;
        prep_seg(tile, w1a, 2304, 1024, win, NIN, 2304, 1024, 1024, gmix, rot); rot += 256;
        prep_seg(tile, w1b, 0, 256, win, NIN, 2176, 128, 1024, gmix, rot); rot += 64;
        prep_seg(tile, w1b, 256, 1024, win, NIN, 2816, 1024, 1024, gmix, rot); rot += 256;
        prep_seg(tile, wg, 0, 3072, win, NIN, 4368, 3072, 1024, gmix, rot); rot += 768;
        prep_seg(tile, wg, 3072, 512, win, NIN, 3840, 512, 1024, gmix, rot); rot += 128;
        prep_seg(tile, (bf16_t*)(wb + LW_WA), 0, 1024, p.in[7] + (size_t)l * 512 * D, D, 0, 1024, 512, nullptr, rot); rot += 128;
        prep_seg(tile, (bf16_t*)(wb + LW_WB), 0, 1024, p.in[8] + (size_t)l * 512 * D, D, 0, 1024, 512, nullptr, rot); rot += 128;
        prep_seg(tile, (bf16_t*)(wb + LW_WC), 0, 1024, p.in[9] + (size_t)l * 512 * D, D, 0, 1024, 512, nullptr, rot); rot += 128;
        prep_seg(tile, (bf16_t*)(wb + LW_WO), 0, 1024, p.in[10] + (size_t)l * D * D, D, 0, 1024, 1024, nullptr, rot); rot += 256;
        prep_seg(tile, (bf16_t*)(wb + LW_WUP), 0, 4096, p.in[13] + (size_t)l * D * 4096, 4096, 0, 4096, 1024, gmlp, rot); rot += 1024;
        prep_seg(tile, (bf16_t*)(wb + LW_WDN), 0, 1024, p.in[14] + (size_t)l * 4096 * D, D, 0, 1024, 4096, nullptr, rot); rot += 1024;
    }
    const int tid0 = otid(), lane = tid0 & 63, gw = obid() * 8 + (tid0 >> 6), NW = gridDim.x * 8;
    bf16_t* xb = (bf16_t*)(p.ws + WS_XB); float* ssq = (float*)(p.ws + WS_SSQ);
    for (int row = gw; row < T; row += NW) {
        const float* x = row < TP ? p.in[0] + (size_t)row * D : p.in[1] + (size_t)(row - TP) * D;
        float s = 0.f;
#pragma unroll
        for (int i = 0; i < 4; ++i) {
            const f32x4 v = *(const f32x4*)(x + i * 256 + lane * 4);
            s += v[0] * v[0] + v[1] * v[1] + v[2] * v[2] + v[3] * v[3];
            u32x2 w; w.x = pk2(v[0], v[1]); w.y = pk2(v[2], v[3]);
            *(u32x2*)(xb + (size_t)row * D + i * 256 + lane * 4) = w;
        }
#pragma unroll
        for (int d = 32; d >= 1; d >>= 1) s += __shfl_xor(s, d);
        if (lane == 0) ssq[row] = s;
    }
    for (int i = obid() * 512 + tid0; i < 4 * T; i += gridDim.x * 512) ssq[T + i] = 0.f;
}

DI void seq_bounds(int t, int& lo, int& hi) { if (t < TP) { lo = t & ~2047; hi = lo + 2048; } else { lo = TP; hi = T; } }

DI void conv_phase(const Params& p, int l) {
    bf16_t* cb = (bf16_t*)(p.ws + WS_NAT); const bf16_t* cc = cb + (size_t)T * 512; const bf16_t* cx = cc + (size_t)T * 512;
    const float* cw = p.in[3] + l * 3 * 512;
    for (int it = obid() * 512 + otid(); it < T * 64; it += gridDim.x * 512) {
        const int t = it >> 6, c0 = (it & 63) * 8;
        int lo, hi; seq_bounds(t, lo, hi);
        float accv[8];
#pragma unroll
        for (int j = 0; j < 8; ++j) accv[j] = 0.f;
#pragma unroll
        for (int dt = -1; dt <= 1; ++dt) {
            const int tt = t + dt;
            if (tt >= lo && tt < hi) {
                const u32x4 a = *(const u32x4*)(cc + (size_t)tt * 512 + c0), b = *(const u32x4*)(cx + (size_t)tt * 512 + c0);
                f32x4 a0, a1, b0, b1; unpack8(a, a0, a1); unpack8(b, b0, b1);
                const f32x4 w0 = *(const f32x4*)(cw + (dt + 1) * 512 + c0), w1 = *(const f32x4*)(cw + (dt + 1) * 512 + c0 + 4);
#pragma unroll
                for (int j = 0; j < 4; ++j) { accv[j] += w0[j] * a0[j] * b0[j]; accv[4 + j] += w1[j] * a1[j] * b1[j]; }
            }
        }
        u32x4* pb = (u32x4*)(cb + (size_t)t * 512 + c0);
        f32x4 g0, g1; unpack8(*pb, g0, g1);
        f32x4 r0, r1;
#pragma unroll
        for (int j = 0; j < 4; ++j) { r0[j] = g0[j] * accv[j]; r1[j] = g1[j] * accv[4 + j]; }
        *pb = pack8v(r0, r1);
    }
}

DI void attn_item(int strip, int h, bf16_t* aq, const bf16_t* ak, const bf16_t* xt, float sink, int lane) {
    const int c = lane & 31, hh = lane >> 5, t0 = strip * 32, hk = h >> 2, tq = t0 + c;
    int lo, hi; seq_bounds(t0, lo, hi);
    const float slope = exp2f(-(float)(h + 1));
    bf16x8 qf[4];
#pragma unroll
    for (int ks = 0; ks < 4; ++ks) qf[ks] = *(const bf16x8*)(aq + (size_t)tq * 512 + h * 64 + ks * 16 + hh * 8);
    const int krow = swap23(c);
    float m = sink, sum = hh == 0 ? 1.f : 0.f;
    f32x16 o0, o1;
#pragma unroll
    for (int v = 0; v < 16; ++v) { o0[v] = 0.f; o1[v] = 0.f; }
#pragma unroll 1
    for (int g3 = 0; g3 < 3; ++g3) {
        f32x16 S[3]; bf16x8 vf[3][2][2];
        float gm = m;
#pragma unroll
        for (int j = 0; j < 3; ++j) {
            const int kb = t0 - 128 + 32 * (3 * g3 + j);
            const bool tv = kb >= lo && kb < hi;
            const int kbc = tv ? kb : t0;
            const bf16_t* kp = ak + (size_t)(kbc + krow) * 128 + hk * 64 + hh * 8;
            f32x16 a;
#pragma unroll
            for (int v = 0; v < 16; ++v) a[v] = 0.f;
#pragma unroll
            for (int ks = 0; ks < 4; ++ks) { const bf16x8 kf = *(const bf16x8*)(kp + ks * 16); a = MFMA32(kf, qf[ks], a); }
#pragma unroll
            for (int s2 = 0; s2 < 2; ++s2) {
                vf[j][s2][0] = *(const bf16x8*)(xt + xt_off(hk * 64 + c, kbc) + 16 * s2 + 8 * hh);
                vf[j][s2][1] = *(const bf16x8*)(xt + xt_off(hk * 64 + 32 + c, kbc) + 16 * s2 + 8 * hh);
            }
#pragma unroll
            for (int v = 0; v < 16; ++v) {
                const int key = kb + (v & 7) + 8 * hh + 16 * (v >> 3);
                const int ar = key > tq ? key - tq : tq - key;
                float sc_ = a[v] * 0.125f - slope * (float)ar;
                sc_ = (tv && ar <= 128) ? sc_ : -INFINITY;
                a[v] = sc_; gm = fmaxf(gm, sc_);
            }
            S[j] = a;
        }
        gm = fmaxf(gm, __shfl_xor(gm, 32));
        const float alpha = __expf(m - gm); m = gm; sum *= alpha;
#pragma unroll
        for (int v = 0; v < 16; ++v) { o0[v] *= alpha; o1[v] *= alpha; }
#pragma unroll
        for (int j = 0; j < 3; ++j) {
#pragma unroll
            for (int v = 0; v < 16; ++v) { const float pe = __expf(S[j][v] - m); S[j][v] = pe; sum += pe; }
#pragma unroll
            for (int s2 = 0; s2 < 2; ++s2) { const bf16x8 pf = pack8(S[j], s2); o0 = MFMA32(vf[j][s2][0], pf, o0); o1 = MFMA32(vf[j][s2][1], pf, o1); }
        }
    }
    sum += __shfl_xor(sum, 32);
    const float inv = 1.0f / sum;
    bf16_t* op = aq + (size_t)tq * 512 + h * 64 + 4 * hh;
#pragma unroll
    for (int g = 0; g < 4; ++g) {
        u32x2 w0, w1;
        w0.x = pk2(o0[4 * g] * inv, o0[4 * g + 1] * inv); w0.y = pk2(o0[4 * g + 2] * inv, o0[4 * g + 3] * inv);
        w1.x = pk2(o1[4 * g] * inv, o1[4 * g + 1] * inv); w1.y = pk2(o1[4 * g + 2] * inv, o1[4 * g + 3] * inv);
        *(u32x2*)(op + 8 * g) = w0; *(u32x2*)(op + 32 + 8 * g) = w1;
    }
}

DI float logsigmoidf_(float x) { return fminf(x, 0.f) - log1pf(expf(-fabsf(x))); }
DI float scan_up(float v, int lane) {
#pragma unroll
    for (int d = 1; d < 64; d <<= 1) { const float t = __shfl_up(v, d); if (lane >= d) v += t; }
    return v;
}
DI float scan_down(float v, int lane) {
#pragma unroll
    for (int d = 1; d < 64; d <<= 1) { const float t = __shfl_down(v, d); if (lane + d < 64) v += t; }
    return v;
}
DI float wave_max(float v) {
#pragma unroll
    for (int d = 32; d >= 1; d >>= 1) v = fmaxf(v, __shfl_xor(v, d));
    return v;
}
#define LDS_FENCE() asm volatile("s_waitcnt lgkmcnt(0)" ::: "memory")

DI void mstat_item(int cg, int hd, int dir, unsigned char* ws, LAS float* wl, int lane) {
    const int tb = cg * 128, c = lane & 31, hh = lane >> 5, item = cg * 4 + hd;
    const float* gates = (const float*)(ws + WS_GATES);
    const float ig0 = gates[(size_t)(tb + lane) * 16 + dir * 8 + hd], fg0 = gates[(size_t)(tb + lane) * 16 + dir * 8 + 4 + hd];
    const float ig1 = gates[(size_t)(tb + 64 + lane) * 16 + dir * 8 + hd], fg1 = gates[(size_t)(tb + 64 + lane) * 16 + dir * 8 + 4 + hd];
    const float lf0 = logsigmoidf_(fg0), lf1 = logsigmoidf_(fg1);
    float b0, b1, g;
    if (dir == 0) { b0 = scan_up(lf0, lane); const float t0 = __shfl(b0, 63); b1 = scan_up(lf1, lane) + t0; g = __shfl(b1, 63); }
    else { b1 = scan_down(lf1, lane); const float t1 = __shfl(b1, 0); b0 = scan_down(lf0, lane) + t1; g = __shfl(b0, 0); }
    const float w0 = g - b0 + ig0, w1 = g - b1 + ig1;
    const float mloc = wave_max(fmaxf(w0, w1));
    const float DHS = 0.08838834764831845f;
    float* barr = (float*)(ws + WS_BARR) + (size_t)(dir * 4 + hd) * T + tb;
    barr[lane] = b0; barr[64 + lane] = b1;
    LDS_FENCE();
    wl[lane] = __expf(w0 - mloc) * DHS; wl[64 + lane] = __expf(w1 - mloc) * DHS;
    LDS_FENCE();
    float* sc = (float*)(ws + WS_SC);
    if (lane == 0) { sc[dir * 1024 + item] = g; sc[2048 + dir * 1024 + item] = mloc; }
    const bf16_t* mkT = (const bf16_t*)(ws + WS_XT) + xt_off(128 + hd * 128, tb);
    const bf16_t* mvT = mkT + (size_t)512 * 32;
    bf16_t* st = (bf16_t*)(ws + WS_ST) + (size_t)(dir * 1024 + item) * 16384;
#pragma unroll 1
    for (int vt = 0; vt < 4; ++vt) {
        bf16x8 vb[8];
#pragma unroll
        for (int ks = 0; ks < 8; ++ks) {
            const u32x4 raw = *(const u32x4*)(mvT + (size_t)(vt * 32 + c) * 32 + (size_t)(ks >> 1) * (1152 * 32) + 16 * (ks & 1) + 8 * hh);
            const f32x4 e0 = *(const LAS f32x4*)(wl + 16 * ks + 8 * hh), e1 = *(const LAS f32x4*)(wl + 16 * ks + 8 * hh + 4);
            f32x4 x0, x1; unpack8(raw, x0, x1);
            vb[ks] = __builtin_bit_cast(bf16x8, pack8v(x0 * e0, x1 * e1));
        }
#pragma unroll
        for (int kt = 0; kt < 4; ++kt) {
            f32x16 acc;
#pragma unroll
            for (int v = 0; v < 16; ++v) acc[v] = 0.f;
#pragma unroll
            for (int ks = 0; ks < 8; ++ks) { const bf16x8 kf = *(const bf16x8*)(mkT + (size_t)(kt * 32 + c) * 32 + (size_t)(ks >> 1) * (1152 * 32) + 16 * (ks & 1) + 8 * hh); acc = MFMA32(kf, vb[ks], acc); }
#pragma unroll
            for (int gq = 0; gq < 4; ++gq) {
                u32x2 w; w.x = pk2(acc[4 * gq], acc[4 * gq + 1]); w.y = pk2(acc[4 * gq + 2], acc[4 * gq + 3]);
                *(u32x2*)(st + (size_t)(vt * 32 + c) * 128 + kt * 32 + 8 * gq + 4 * hh) = w;
            }
        }
    }
    float* nl = (float*)(ws + WS_NL) + (size_t)(dir * 1024 + item) * 128;
#pragma unroll 1
    for (int kk = 0; kk < 2; ++kk) {
        const int k = lane + 64 * kk; float s = 0.f;
#pragma unroll
        for (int s8 = 0; s8 < 16; ++s8) {
            const u32x4 raw = *(const u32x4*)(mkT + (size_t)k * 32 + (size_t)(s8 >> 2) * (1152 * 32) + 8 * (s8 & 3));
            const f32x4 e0 = *(const LAS f32x4*)(wl + 8 * s8), e1 = *(const LAS f32x4*)(wl + 8 * s8 + 4);
            f32x4 x0, x1; unpack8(raw, x0, x1);
#pragma unroll
            for (int j = 0; j < 4; ++j) s += x0[j] * e0[j] + x1[j] * e1[j];
        }
        nl[k] = s;
    }
    LDS_FENCE();
}

DI void phase_mix(const Params& p, int l, LAS unsigned char* lds) {
    const int tid0 = otid(), lane = tid0 & 63, wid = tid0 >> 6, gw = obid() * 8 + wid, NW = gridDim.x * 8;
    LAS float* wl = (LAS float*)(lds + wid * 4096);
    for (int it = gw; it < 2048; it += NW) mstat_item(it >> 3, (it >> 1) & 3, it & 1, p.ws, wl, lane);
    bf16_t* aq = (bf16_t*)(p.ws + WS_NAT + 3 * MB_ARR); const bf16_t* ak = (const bf16_t*)(p.ws + WS_AK); const bf16_t* avT = (const bf16_t*)(p.ws + WS_XT);
    for (int it = gw; it < 8192; it += NW) { const int h = it & 7; attn_item(it >> 3, h, aq, ak, avT, p.in[4][l * 8 + h], lane); }
    conv_phase(p, l);
}

DI void phase_scan(const Params& p) {
    const int gt = obid() * 512 + otid(), NT = gridDim.x * 512;
    const float* __restrict__ sc = (const float*)(p.ws + WS_SC); float* __restrict__ mprev = (float*)(p.ws + WS_SC) + 4096;
    bf16_t* st = (bf16_t*)(p.ws + WS_ST);
    const float* __restrict__ nl = (const float*)(p.ws + WS_NL); float* __restrict__ np = (float*)(p.ws + WS_NP);
    for (int task = gt; task < 64 * 2048; task += NT) {
        const int chain = task >> 11, vec = task & 2047, dir = chain >> 5, seq = (chain & 31) >> 2, hd = chain & 3;
        float stv[8];
#pragma unroll
        for (int j = 0; j < 8; ++j) stv[j] = 0.f;
        float m = -1e30f;
#pragma unroll 1
        for (int i0 = 0; i0 < 16; i0 += 8) {
            u32x4 xv[8]; float gv[8], mv[8];
#pragma unroll
            for (int j = 0; j < 8; ++j) {
                const int i = i0 + j, cg = seq * 16 + (dir ? 15 - i : i), item = cg * 4 + hd;
                xv[j] = *(const u32x4*)(st + (size_t)(dir * 1024 + item) * 16384 + vec * 8);
                gv[j] = sc[dir * 1024 + item]; mv[j] = sc[2048 + dir * 1024 + item];
            }
#pragma unroll
            for (int j = 0; j < 8; ++j) {
                const int i = i0 + j, cg = seq * 16 + (dir ? 15 - i : i), item = cg * 4 + hd;
                const float mn = fmaxf(gv[j] + m, mv[j]), a = __expf(gv[j] + m - mn), cc = __expf(mv[j] - mn);
                f32x4 x0, x1; unpack8(xv[j], x0, x1);
                const f32x4 o0 = {stv[0], stv[1], stv[2], stv[3]}, o1 = {stv[4], stv[5], stv[6], stv[7]};
                *(u32x4*)(st + (size_t)(dir * 1024 + item) * 16384 + vec * 8) = pack8v(o0, o1);
#pragma unroll
                for (int q = 0; q < 4; ++q) { stv[q] = a * stv[q] + cc * x0[q]; stv[4 + q] = a * stv[4 + q] + cc * x1[q]; }
                m = mn;
            }
        }
    }
    for (int task = gt; task < 8 * 16384; task += NT) {
        const int chain = task >> 14, el = task & 16383, dir = chain >> 2, hd = chain & 3;
        float s = 0.f, m = -1e30f;
#pragma unroll 1
        for (int i0 = 0; i0 < 128; i0 += 16) {
            bf16_t xv[16]; float gv[16], mv[16];
#pragma unroll
            for (int j = 0; j < 16; ++j) {
                const int i = i0 + j, cg = 128 + (dir ? 127 - i : i), item = cg * 4 + hd;
                xv[j] = st[(size_t)(dir * 1024 + item) * 16384 + el];
                gv[j] = sc[dir * 1024 + item]; mv[j] = sc[2048 + dir * 1024 + item];
            }
#pragma unroll
            for (int j = 0; j < 16; ++j) {
                const int i = i0 + j, cg = 128 + (dir ? 127 - i : i), item = cg * 4 + hd;
                const float mn = fmaxf(gv[j] + m, mv[j]), a = __expf(gv[j] + m - mn), cc = __expf(mv[j] - mn);
                st[(size_t)(dir * 1024 + item) * 16384 + el] = (bf16_t)(pk2(s, 0.f) & 0xffffu);
                s = a * s + cc * __uint_as_float((unsigned)xv[j] << 16);
                m = mn;
            }
        }
    }
    for (int task = gt; task < 72 * 128; task += NT) {
        const int chain = task >> 7, k = task & 127;
        int dir, hd, c0, nc;
        if (chain < 64) { dir = chain >> 5; hd = chain & 3; c0 = ((chain & 31) >> 2) * 16; nc = 16; }
        else { dir = (chain - 64) >> 2; hd = chain & 3; c0 = 128; nc = 128; }
        float s = 0.f, m = -1e30f;
#pragma unroll 1
        for (int i0 = 0; i0 < nc; i0 += 16) {
            float xv[16], gv[16], mv[16];
#pragma unroll
            for (int j = 0; j < 16; ++j) {
                const int i = i0 + j, cg = c0 + (dir ? nc - 1 - i : i), item = cg * 4 + hd;
                xv[j] = nl[(size_t)(dir * 1024 + item) * 128 + k];
                gv[j] = sc[dir * 1024 + item]; mv[j] = sc[2048 + dir * 1024 + item];
            }
#pragma unroll
            for (int j = 0; j < 16; ++j) {
                const int i = i0 + j, cg = c0 + (dir ? nc - 1 - i : i), item = cg * 4 + hd;
                const float mn = fmaxf(gv[j] + m, mv[j]), a = __expf(gv[j] + m - mn), cc = __expf(mv[j] - mn);
                np[(size_t)(dir * 1024 + item) * 128 + k] = s;
                if (k == 0) mprev[dir * 1024 + item] = m;
                s = a * s + cc * xv[j]; m = mn;
            }
        }
    }
}

DI void mout_item(int cg, int hd, int ts, unsigned char* ws, LAS float* wl, int lane) {
    const int tb = cg * 128, t0 = tb + ts * 32, c = lane & 31, hh = lane >> 5, item = cg * 4 + hd, tl = ts * 32 + c;
    const float* gates = (const float*)(ws + WS_GATES);
    const float* bf_ = (const float*)(ws + WS_BARR) + (size_t)hd * T + tb;
    const float* bb_ = (const float*)(ws + WS_BARR) + (size_t)(4 + hd) * T + tb;
    LDS_FENCE();
    wl[lane] = bf_[lane] - gates[(size_t)(tb + lane) * 16 + hd];
    wl[64 + lane] = bf_[64 + lane] - gates[(size_t)(tb + 64 + lane) * 16 + hd];
    wl[128 + lane] = bb_[lane] - gates[(size_t)(tb + lane) * 16 + 8 + hd];
    wl[192 + lane] = bb_[64 + lane] - gates[(size_t)(tb + 64 + lane) * 16 + 8 + hd];
    LDS_FENCE();
    const float bft = bf_[tl], bbt = bb_[tl];
    const float* mprev = (const float*)(ws + WS_SC) + 4096;
    const float mpf = mprev[item], mpb = mprev[1024 + item];
    bf16_t* mq = (bf16_t*)(ws + WS_NAT + 4 * MB_ARR); const bf16_t* mk = mq + (size_t)T * 512;
    const bf16_t* mvT = (const bf16_t*)(ws + WS_XT) + xt_off(640 + hd * 128, tb);
    bf16x8 qf[8];
#pragma unroll
    for (int ks = 0; ks < 8; ++ks) qf[ks] = *(const bf16x8*)(mq + (size_t)(t0 + c) * 512 + hd * 128 + ks * 16 + hh * 8);
    const float DHS = 0.08838834764831845f;
    float mf = bft + mpf, mb = bbt + mpb;
#pragma unroll 2
    for (int blk = 0; blk < 8; ++blk) {
        const int sb = 64 * hh + 8 * blk;
        const f32x4 uf0 = *(const LAS f32x4*)(wl + sb), uf1 = *(const LAS f32x4*)(wl + sb + 4);
        const f32x4 ub0 = *(const LAS f32x4*)(wl + 128 + sb), ub1 = *(const LAS f32x4*)(wl + 128 + sb + 4);
#pragma unroll
        for (int j = 0; j < 8; ++j) {
            const int sl = sb + j; const float uf = j < 4 ? uf0[j & 3] : uf1[j & 3], ub = j < 4 ? ub0[j & 3] : ub1[j & 3];
            mf = fmaxf(mf, sl <= tl ? bft - uf : -INFINITY);
            mb = fmaxf(mb, sl >= tl ? bbt - ub : -INFINITY);
        }
    }
    mf = fmaxf(mf, __shfl_xor(mf, 32)); mb = fmaxf(mb, __shfl_xor(mb, 32));
    const int krow = swap23(c);
    const float kf_ = bft - mf, kb_ = bbt - mb;
    const bf16_t* kbase = mk + (size_t)(tb + krow) * 512 + hd * 128 + hh * 8;
    float rsf = 0.f, rsb = 0.f;
#pragma unroll 1
    for (int stt = 0; stt < 4; ++stt) {
        f32x16 a;
#pragma unroll
        for (int v = 0; v < 16; ++v) a[v] = 0.f;
        const bf16_t* kp = kbase + (size_t)(32 * stt) * 512;
#pragma unroll
        for (int ks = 0; ks < 8; ++ks) { const bf16x8 kf = *(const bf16x8*)(kp + ks * 16); a = MFMA32(kf, qf[ks], a); }
#pragma unroll
        for (int v8 = 0; v8 < 2; ++v8) {
            const int sb = 32 * stt + 16 * v8 + 8 * hh;
            const f32x4 uf0 = *(const LAS f32x4*)(wl + sb), uf1 = *(const LAS f32x4*)(wl + sb + 4);
            const f32x4 ub0 = *(const LAS f32x4*)(wl + 128 + sb), ub1 = *(const LAS f32x4*)(wl + 128 + sb + 4);
#pragma unroll
            for (int j = 0; j < 8; ++j) {
                const int sl = sb + j; const float uf = j < 4 ? uf0[j & 3] : uf1[j & 3], ub = j < 4 ? ub0[j & 3] : ub1[j & 3];
                const float sv = a[8 * v8 + j];
                rsf += sl <= tl ? __expf(kf_ - uf) * sv : 0.f; rsb += sl >= tl ? __expf(kb_ - ub) * sv : 0.f;
            }
        }
    }
    rsf *= DHS; rsb *= DHS;
    rsf += __shfl_xor(rsf, 32); rsb += __shfl_xor(rsb, 32);
    const float* nf = (const float*)(ws + WS_NP) + (size_t)item * 128; const float* nb = nf + (size_t)1024 * 128;
    float nqf = 0.f, nqb = 0.f;
#pragma unroll
    for (int ks = 0; ks < 8; ++ks) {
        f32x4 q0, q1; unpack8(__builtin_bit_cast(u32x4, qf[ks]), q0, q1);
        const f32x4 a0 = *(const f32x4*)(nf + ks * 16 + hh * 8), a1 = *(const f32x4*)(nf + ks * 16 + hh * 8 + 4);
        const f32x4 c0 = *(const f32x4*)(nb + ks * 16 + hh * 8), c1 = *(const f32x4*)(nb + ks * 16 + hh * 8 + 4);
#pragma unroll
        for (int j = 0; j < 4; ++j) { nqf += q0[j] * a0[j] + q1[j] * a1[j]; nqb += q0[j] * c0[j] + q1[j] * c1[j]; }
    }
    nqf += __shfl_xor(nqf, 32); nqb += __shfl_xor(nqb, 32);
    const float af = __expf(bft + mpf - mf), ab = __expf(bbt + mpb - mb);
    const float denf = rsf + af * nqf, denb = rsb + ab * nqb;
    const float idf = 1.0f / fmaxf(fabsf(denf), __expf(-mf)), idb = 1.0f / fmaxf(fabsf(denb), __expf(-mb));
    const float cf = af * idf, cbk = ab * idb;
    f32x16 aP[4];
#pragma unroll
    for (int d = 0; d < 4; ++d)
#pragma unroll
        for (int v = 0; v < 16; ++v) aP[d][v] = 0.f;
    const float sF = idf * DHS, sB = idb * DHS;
    const bf16_t* vbase = mvT + (size_t)c * 32 + 8 * hh;
#pragma unroll 1
    for (int stt = 0; stt < 4; ++stt) {
        f32x16 a;
#pragma unroll
        for (int v = 0; v < 16; ++v) a[v] = 0.f;
        const bf16_t* kp = kbase + (size_t)(32 * stt) * 512;
#pragma unroll
        for (int ks = 0; ks < 8; ++ks) { const bf16x8 kf = *(const bf16x8*)(kp + ks * 16); a = MFMA32(kf, qf[ks], a); }
        bf16x8 vf[4][2];
#pragma unroll
        for (int d = 0; d < 4; ++d)
#pragma unroll
            for (int s2 = 0; s2 < 2; ++s2) vf[d][s2] = *(const bf16x8*)(vbase + (size_t)stt * (1152 * 32) + (size_t)d * (32 * 32) + 16 * s2);
#pragma unroll
        for (int v8 = 0; v8 < 2; ++v8) {
            const int sb = 32 * stt + 16 * v8 + 8 * hh;
            const f32x4 uf0 = *(const LAS f32x4*)(wl + sb), uf1 = *(const LAS f32x4*)(wl + sb + 4);
            const f32x4 ub0 = *(const LAS f32x4*)(wl + 128 + sb), ub1 = *(const LAS f32x4*)(wl + 128 + sb + 4);
#pragma unroll
            for (int j = 0; j < 8; ++j) {
                const int sl = sb + j; const float uf = j < 4 ? uf0[j & 3] : uf1[j & 3], ub = j < 4 ? ub0[j & 3] : ub1[j & 3];
                const float sv = a[8 * v8 + j];
                const float wf = sl <= tl ? __expf(kf_ - uf) * sF : 0.f, wb = sl >= tl ? __expf(kb_ - ub) * sB : 0.f;
                a[8 * v8 + j] = (wf + wb) * sv;
            }
        }
        const bf16x8 p0 = pack8(a, 0), p1 = pack8(a, 1);
#pragma unroll
        for (int d = 0; d < 4; ++d) { aP[d] = MFMA32(vf[d][0], p0, aP[d]); aP[d] = MFMA32(vf[d][1], p1, aP[d]); }
    }
    const bf16_t* Cf = (const bf16_t*)(ws + WS_ST) + (size_t)item * 16384 + (size_t)c * 128 + 8 * hh; const bf16_t* Cb = Cf + (size_t)1024 * 16384;
#pragma unroll 2
    for (int ks = 0; ks < 8; ++ks) {
        bf16x8 c1[4], c2[4];
#pragma unroll
        for (int d = 0; d < 4; ++d) { c1[d] = *(const bf16x8*)(Cf + (size_t)d * (32 * 128) + 16 * ks); c2[d] = *(const bf16x8*)(Cb + (size_t)d * (32 * 128) + 16 * ks); }
        f32x4 q0, q1; unpack8(__builtin_bit_cast(u32x4, qf[ks]), q0, q1);
        const bf16x8 qF = __builtin_bit_cast(bf16x8, pack8v(q0 * cf, q1 * cf)), qB = __builtin_bit_cast(bf16x8, pack8v(q0 * cbk, q1 * cbk));
#pragma unroll
        for (int d = 0; d < 4; ++d) { aP[d] = MFMA32(c1[d], qF, aP[d]); aP[d] = MFMA32(c2[d], qB, aP[d]); }
    }
    float ss = 0.f;
    bf16_t* op = mq + (size_t)(t0 + c) * 512 + hd * 128 + 4 * hh;
#pragma unroll
    for (int d = 0; d < 4; ++d)
#pragma unroll
        for (int gq = 0; gq < 4; ++gq) {
#pragma unroll
            for (int j = 0; j < 4; ++j) ss += aP[d][4 * gq + j] * aP[d][4 * gq + j];
            u32x2 w; w.x = pk2(aP[d][4 * gq], aP[d][4 * gq + 1]); w.y = pk2(aP[d][4 * gq + 2], aP[d][4 * gq + 3]);
            *(u32x2*)(op + d * 32 + 8 * gq) = w;
        }
    ss += __shfl_xor(ss, 32);
    if (hh == 0) ((float*)(ws + WS_RN))[(size_t)(t0 + c) * 4 + hd] = __builtin_amdgcn_rsqf(ss * (1.0f / 128.0f) + EPS);
    LDS_FENCE();
}

DI void phase_mout(const Params& p, int l, LAS unsigned char* lds) {
    const int tid0 = otid(), lane = tid0 & 63, wid = tid0 >> 6, gw = obid() * 8 + wid, NW = gridDim.x * 8;
    LAS float* wl = (LAS float*)(lds + wid * 4096);
    for (int it = gw; it < 4096; it += NW) mout_item(it >> 4, (it >> 2) & 3, it & 3, p.ws, wl, lane);
}

DI void phase_final(const Params& p) {
#if TPROBE
    const float eps_p = sqrtf((float)(*(const unsigned*)(p.ws + WS_END)) * 2e-9f);
#endif
    const float* ssq = (const float*)(p.ws + WS_SSQ) + 4 * T; const float* g = p.in[15];
    for (int i = obid() * 512 + otid(); i < T * 256; i += gridDim.x * 512) {
        const int row = i >> 8, c4 = (i & 255) * 4;
        const float r = __builtin_amdgcn_rsqf(ssq[row] * (1.0f / 1024.0f) + EPS);
        f32x4 v = *(f32x4*)(p.out + (size_t)row * D + c4); const f32x4 gg = *(const f32x4*)(g + c4);
        v = v * r * gg;
#if TPROBE
        v[0] += eps_p; v[1] -= eps_p; v[2] += eps_p; v[3] -= eps_p;
#endif
        *(f32x4*)(p.out + (size_t)row * D + c4) = v;
    }
}

DI pg8::Order make_order(const void* A, int nM, const void* B, int nN, int K) {
    pg8::Order o; o.nM0 = nM; o.nN0 = nN; o.n0 = nM * nN; o.nM1 = 0; o.nN1 = 0; o.n1 = 0; o.G = gridDim.x; o.c = obid();
    o.A0 = (const char*)A; o.B0 = (const char*)B; o.A1 = nullptr; o.B1 = nullptr; o.tstep = (size_t)256 * K * 2; return o;
}

__global__ void __launch_bounds__(512, 2) fwd_megakernel(Params p) {
    extern __shared__ __attribute__((aligned(16))) unsigned char lds_raw[];
    LAS unsigned char* lds = (LAS unsigned char*)lds_raw;
    cg::grid_group grid = cg::this_grid();
    unsigned char* ws = p.ws;
    bf16_t* xb = (bf16_t*)(ws + WS_XB); float* ssq = (float*)(ws + WS_SSQ);

#if TPROBE
    unsigned long long tacc = 0, tt0 = __builtin_amdgcn_s_memrealtime();
#endif
    phase_prep(p, lds);
#if TPROBE && TP_PREP
    { const unsigned long long d = __builtin_amdgcn_s_memrealtime() - tt0; while (__builtin_amdgcn_s_memrealtime() - tt0 < 5 * d) __builtin_amdgcn_s_sleep(8); }
#endif
    grid.sync();
    for (int l = 0; l < 2; ++l) {
        unsigned char* wb = ws + WS_W + (size_t)l * LW_SIZE;
        {
            pg8::Order o = make_order(xb, 128, wb + LW_W1A, 13, 1024);
            o.nM1 = 5; o.nN1 = 128; o.n1 = 640; o.A1 = (const char*)(wb + LW_W1B); o.B1 = (const char*)xb;
            EpiP1 e{ws, ssq + (size_t)(2 * l) * T, p.in[5] + l * 16};
            pg8::gemm_phase(lds, 1024, o, e);
        }
        grid.sync();
#if TPROBE && TP_GROUP == 1
        tt0 = __builtin_amdgcn_s_memrealtime();
#endif
        phase_mix(p, l, lds);
        grid.sync();
#if TPROBE && TP_GROUP == 1
        tacc += __builtin_amdgcn_s_memrealtime() - tt0;
#endif
#if TPROBE && TP_GROUP == 2
        tt0 = __builtin_amdgcn_s_memrealtime();
#endif
        phase_scan(p);
        grid.sync();
#if TPROBE && TP_GROUP == 2
        tacc += __builtin_amdgcn_s_memrealtime() - tt0;
#endif
#if TPROBE && TP_GROUP == 3
        tt0 = __builtin_amdgcn_s_memrealtime();
#endif
        phase_mout(p, l, lds);
        grid.sync();
#if TPROBE && TP_GROUP == 3
        tacc += __builtin_amdgcn_s_memrealtime() - tt0;
#endif
        {
            pg8::Order o = make_order(xb, 128, wb + LW_WG, 14, 1024);
            EpiGates e{ws, ssq + (size_t)(2 * l) * T, p.in[6] + l * 512};
            pg8::gemm_phase(lds, 1024, o, e);
        }
        grid.sync();
        { pg8::Order o = make_order(ws + WS_NAT, 128, wb + LW_WA, 4, 512); EpiY<0> e{ws}; pg8::gemm_phase(lds, 512, o, e); }
        grid.sync();
        { pg8::Order o = make_order(ws + WS_NAT + 3 * MB_ARR, 128, wb + LW_WB, 4, 512); EpiY<1> e{ws}; pg8::gemm_phase(lds, 512, o, e); }
        grid.sync();
        { pg8::Order o = make_order(ws + WS_NAT + 4 * MB_ARR, 128, wb + LW_WC, 4, 512); EpiY<2> e{ws}; pg8::gemm_phase(lds, 512, o, e); }
        grid.sync();
        {
            pg8::Order o = make_order(ws + WS_SIG0, 128, wb + LW_WO, 4, 1024);
            EpiRes e{p.in[0], p.in[1], p.out, xb, ssq + (size_t)(2 * l + 1) * T, l == 0};
            pg8::gemm_phase(lds, 1024, o, e);
        }
        grid.sync();
        {
            pg8::Order o = make_order(xb, 128, wb + LW_WUP, 16, 1024);
            EpiUp e{(bf16_t*)(ws + WS_HID), ssq + (size_t)(2 * l + 1) * T};
            pg8::gemm_phase(lds, 1024, o, e);
        }
        grid.sync();
        {
            pg8::Order o = make_order(ws + WS_HID, 128, wb + LW_WDN, 4, 4096);
            EpiRes e{p.in[0], p.in[1], p.out, xb, ssq + (size_t)(2 * l + 2) * T, 0};
            pg8::gemm_phase(lds, 4096, o, e);
        }
#if TPROBE
        if (l == 1 && blockIdx.x == 0 && threadIdx.x == 0) *(unsigned*)(p.ws + WS_END) = (unsigned)tacc;
#endif
        grid.sync();
    }
    phase_final(p);
}

extern "C" void kernel_launch(void* const* d_in, const int* in_sizes, int n_in, void* d_out, int out_size, void* d_ws, size_t ws_size, hipStream_t stream) {
    static int grid_blocks = 0;
    if (grid_blocks == 0) {
        if (n_in != 16 || out_size != T * D || ws_size < WS_END + 256) { fprintf(stderr, "kernel_launch: unexpected shapes (n_in %d out %d ws %zu need %zu)\n", n_in, out_size, ws_size, (size_t)WS_END); grid_blocks = -1; return; }
        int dev = 0, cus = 0, per_cu = 0;
        hipGetDevice(&dev);
        hipDeviceGetAttribute(&cus, hipDeviceAttributeMultiprocessorCount, dev);
        hipFuncSetAttribute((const void*)fwd_megakernel, hipFuncAttributeMaxDynamicSharedMemorySize, pg8::STAGE_BYTES);
        hipOccupancyMaxActiveBlocksPerMultiprocessor(&per_cu, (const void*)fwd_megakernel, 512, pg8::STAGE_BYTES);
        if (per_cu < 1) per_cu = 1;
        grid_blocks = cus;
        (void)hipGetLastError();
    }
    if (grid_blocks < 0) return;
    Params p{};
    for (int i = 0; i < 16; ++i) p.in[i] = (const float*)d_in[i];
    p.out = (float*)d_out; p.ws = (unsigned char*)d_ws;
    void* args[] = {&p};
    hipError_t e = hipLaunchCooperativeKernel((const void*)fwd_megakernel, dim3(grid_blocks), dim3(512), args, pg8::STAGE_BYTES, stream);
    if (e != hipSuccess) fprintf(stderr, "cooperative launch failed: %s (grid %d)\n", hipGetErrorString(e), grid_blocks);
}
```
